# Optimizing an MI355X kernel written in HIP

```python
import math
import jax, jax.numpy as jnp
from jax import lax
import numpy as np


D_MODEL = 1024
BATCH = 4
SEQ = 4096
DEPTH = 2
DEC_BATCH = 8
DEC_SEQ = 2048
PAST_LEN = 128

GRID_W = 64
BLOCK = 128
EPS = 1e-6
ROPE_THETA = 10000.0

A_HEADS = 8
A_KV_HEADS = 2
A_HEAD_DIM = 64
A_GROUP = A_HEADS // A_KV_HEADS
A_WIDTH = A_HEADS * A_HEAD_DIM
A_KV_WIDTH = A_KV_HEADS * A_HEAD_DIM

B_HEADS = 4
B_KEY_DIM = 64
B_VAL_DIM = 128
RET_CHUNK = 128
B_QK_WIDTH = B_HEADS * B_KEY_DIM
B_V_WIDTH = B_HEADS * B_VAL_DIM

C_HEADS = 16
C_KV_HEADS = 2
C_HEAD_DIM = 64
C_GROUP = C_HEADS // C_KV_HEADS
C_WIDTH = C_HEADS * C_HEAD_DIM
C_KV_WIDTH = C_KV_HEADS * C_HEAD_DIM
WINDOW = 128
REL_BUCKETS = 32
REL_MAX_DIST = 128

AB_SPLITS = [A_WIDTH, A_KV_WIDTH, A_KV_WIDTH, A_WIDTH, B_QK_WIDTH, B_QK_WIDTH, B_V_WIDTH, B_V_WIDTH]
AB_IN = sum(AB_SPLITS)
AB_OUT = A_WIDTH + B_V_WIDTH
C_IN = 2 * C_WIDTH + 2 * C_KV_WIDTH
C_OUT = C_WIDTH
N_EVEN = (DEPTH + 1) // 2
N_ODD = DEPTH // 2

kernel_name = 'hybrid_axial_retention_window_encoder'

F32 = jnp.float32


def rmsnorm(x, g):
    xf = x.astype(F32)
    y = xf * lax.rsqrt(jnp.mean(xf * xf, axis=-1, keepdims=True) + EPS)
    if g is not None:
        y = y * g.astype(F32)
    return y.astype(x.dtype)


def rotate_pairs(x, ang):
    d = x.shape[-1]
    xf = x.astype(F32).reshape(*x.shape[:-1], d // 2, 2)
    cos = jnp.cos(ang)[:, None, :]
    sin = jnp.sin(ang)[:, None, :]
    x0, x1 = xf[..., 0], xf[..., 1]
    out = jnp.stack([x0 * cos - x1 * sin, x0 * sin + x1 * cos], axis=-1)
    return out.reshape(x.shape).astype(x.dtype)


def axial_angles(n):
    rows = n // GRID_W
    row = jnp.repeat(jnp.arange(rows, dtype=F32), GRID_W)
    col = jnp.tile(jnp.arange(GRID_W, dtype=F32), rows)
    quarter = A_HEAD_DIM // 4
    freqs = ROPE_THETA ** (-jnp.arange(quarter, dtype=F32) / quarter)
    return jnp.concatenate([row[:, None] * freqs, col[:, None] * freqs], axis=-1)


def linear_angles(n, d):
    half = d // 2
    freqs = ROPE_THETA ** (-jnp.arange(half, dtype=F32) / half)
    return jnp.arange(n, dtype=F32)[:, None] * freqs


def dense_gqa(q, k, v):
    b, n = q.shape[:2]
    nb = n // BLOCK
    qb = q.reshape(b, nb, BLOCK, *q.shape[2:]).swapaxes(0, 1)

    def attend(qblk):
        s = jnp.einsum('bqkgd,bskd->bkgqs', qblk, k).astype(F32)
        p = jax.nn.softmax(s, axis=-1).astype(v.dtype)
        return jnp.einsum('bkgqs,bskd->bqkgd', p, v)

    o = lax.map(attend, qb)
    return o.swapaxes(0, 1).reshape(b, n, -1)


def t5_bucket(rel):
    half = REL_BUCKETS // 2
    max_exact = half // 2
    ret = (rel > 0).astype(np.int32) * half
    dist = np.abs(rel)
    large = max_exact + (np.log(np.maximum(dist, 1) / max_exact) / np.log(REL_MAX_DIST / max_exact)
                         * (half - max_exact)).astype(np.int32)
    large = np.minimum(large, half - 1)
    return ret + np.where(dist < max_exact, dist, large)


def banded_sink_gqa(q, k, v, sink, rel_bias):
    b, n, kvh, grp, hd = q.shape
    nb = n // BLOCK
    pad = ((0, 0), (BLOCK, BLOCK), (0, 0), (0, 0))
    kp = jnp.pad(k, pad).reshape(b, nb + 2, BLOCK, kvh, hd)
    vp = jnp.pad(v, pad).reshape(b, nb + 2, BLOCK, kvh, hd)
    kwin = jnp.concatenate([kp[:, j:j + nb] for j in range(3)], axis=2)
    vwin = jnp.concatenate([vp[:, j:j + nb] for j in range(3)], axis=2)
    rel = np.arange(3 * BLOCK)[None, :] - BLOCK - np.arange(BLOCK)[:, None]
    in_win = jnp.asarray(np.abs(rel) <= WINDOW)
    bias = rel_bias[jnp.asarray(t5_bucket(rel))].astype(F32)
    bias = bias.transpose(2, 0, 1).reshape(kvh, grp, BLOCK, 3 * BLOCK)
    kpos = (jnp.arange(nb)[:, None] - 1) * BLOCK + jnp.arange(3 * BLOCK)[None, :]
    kvalid = (kpos >= 0) & (kpos < n)
    mask = in_win[None] & kvalid[:, None, :]
    sink_l = sink.reshape(kvh, grp)[..., None, None].astype(F32)
    qb = q.reshape(b, nb, BLOCK, kvh, grp, hd).swapaxes(0, 1)

    def attend(args):
        qblk, kblk, vblk, m = args
        s = jnp.einsum('bqkgd,bskd->bkgqs', qblk, kblk).astype(F32) + bias
        s = jnp.where(m, s, -jnp.inf)
        mx = jnp.maximum(jnp.max(s, axis=-1, keepdims=True), sink_l)
        e = jnp.exp(s - mx)
        denom = jnp.sum(e, axis=-1, keepdims=True) + jnp.exp(sink_l - mx)
        p = (e / denom).astype(vblk.dtype)
        return jnp.einsum('bkgqs,bskd->bqkgd', p, vblk)

    o = lax.map(attend, (qb, kwin.swapaxes(0, 1), vwin.swapaxes(0, 1), mask))
    return o.swapaxes(0, 1).reshape(b, n, -1)


def retention(q, k, v, log_gamma, inclusive):
    b, n, h, dk = q.shape
    dv = v.shape[-1]
    c = RET_CHUNK
    nc = n // c
    qc = q.reshape(b, nc, c, h, dk)
    kc = k.reshape(b, nc, c, h, dk)
    vc = v.reshape(b, nc, c, h, dv)
    idx = jnp.arange(c, dtype=F32)
    diff = idx[:, None] - idx[None, :]
    mask = (diff >= 0) if inclusive else (diff > 0)
    intra_decay = jnp.where(mask, jnp.exp(log_gamma[:, None, None] * jnp.where(mask, diff, 0.0)), 0.0)
    s = jnp.einsum('bnihd,bnjhd->bnhij', qc, kc) * intra_decay
    intra = jnp.einsum('bnhij,bnjhe->bnihe', s, vc)
    q_decay = jnp.exp((idx[:, None] + 1.0) * log_gamma[None, :])
    k_decay = jnp.exp((c - 1.0 - idx)[:, None] * log_gamma[None, :])
    chunk_decay = jnp.exp(c * log_gamma)
    kv = jnp.einsum('bnjhd,bnjhe->nbhde', kc * k_decay[:, :, None], vc)

    def step(state, kv_n):
        return state * chunk_decay[:, None, None] + kv_n, state

    _, states = lax.scan(step, jnp.zeros((b, h, dk, dv), F32), kv)
    cross = jnp.einsum('bnihd,nbhde->bnihe', qc * q_decay[:, :, None], states)
    return (intra + cross).reshape(b, n, h, dv)


def attn_retention_layer(x, g, w_in, qk_gain, ret_decay, w_out):
    b, n, _ = x.shape
    z = rmsnorm(x, g) @ w_in
    cuts = [int(i) for i in np.cumsum(AB_SPLITS)[:-1]]
    qa, ka, va, ga, qb, kb, vb, gb = jnp.split(z, cuts, axis=-1)
    ang = axial_angles(n)
    qa = rotate_pairs(rmsnorm(qa.reshape(b, n, A_HEADS, A_HEAD_DIM), qk_gain[0]), ang) * (A_HEAD_DIM ** -0.5)
    ka = rotate_pairs(rmsnorm(ka.reshape(b, n, A_KV_HEADS, A_HEAD_DIM), qk_gain[1]), ang)
    va = va.reshape(b, n, A_KV_HEADS, A_HEAD_DIM)
    oa = dense_gqa(qa.reshape(b, n, A_KV_HEADS, A_GROUP, A_HEAD_DIM), ka, va)
    ang_b = linear_angles(n, B_KEY_DIM)
    qb = rotate_pairs(qb.reshape(b, n, B_HEADS, B_KEY_DIM), ang_b).astype(F32)
    kb = rotate_pairs(kb.reshape(b, n, B_HEADS, B_KEY_DIM), ang_b).astype(F32) * (B_KEY_DIM ** -0.5)
    vb = vb.reshape(b, n, B_HEADS, B_VAL_DIM).astype(F32)
    log_gamma = -jnp.exp(ret_decay.astype(F32))
    fwd = retention(qb, kb, vb, log_gamma[0], True)
    bwd = jnp.flip(retention(jnp.flip(qb, 1), jnp.flip(kb, 1), jnp.flip(vb, 1), log_gamma[1], False), 1)
    ob = rmsnorm(fwd + bwd, None).reshape(b, n, B_V_WIDTH).astype(x.dtype)
    mixed = jnp.concatenate([jax.nn.silu(ga) * oa, jax.nn.silu(gb) * ob], axis=-1)
    return x + mixed @ w_out


def windowed_layer(x, g, w_in, sink, rel_bias, w_out):
    b, n, _ = x.shape
    z = rmsnorm(x, g) @ w_in
    q, k, v, gate = jnp.split(z, [C_WIDTH, C_WIDTH + C_KV_WIDTH, C_WIDTH + 2 * C_KV_WIDTH], axis=-1)
    q = q.reshape(b, n, C_KV_HEADS, C_GROUP, C_HEAD_DIM) * (C_HEAD_DIM ** -0.5)
    k = k.reshape(b, n, C_KV_HEADS, C_HEAD_DIM)
    v = v.reshape(b, n, C_KV_HEADS, C_HEAD_DIM)
    o = banded_sink_gqa(q, k, v, sink, rel_bias)
    return x + (jax.nn.silu(gate) * o) @ w_out


def trunk(x, norm_g, w_in_ab, qk_norm_a, ret_decay, w_out_ab, w_in_c, sink_c, w_out_c, rel_bias, final_norm):
    for layer in range(DEPTH):
        i = layer // 2
        if layer % 2 == 0:
            x = attn_retention_layer(x, norm_g[layer], w_in_ab[i], qk_norm_a[i], ret_decay[i], w_out_ab[i])
        else:
            x = windowed_layer(x, norm_g[layer], w_in_c[i], sink_c[i], rel_bias, w_out_c[i])
    return rmsnorm(x, final_norm)


def setup_inputs(seed: int = 0) -> dict:
    key = jax.random.key(seed)
    ks = jax.random.split(key, 12)
    nrm = jax.random.normal
    base_decay = np.log(-np.log(1.0 - 2.0 ** (-5.0 - np.arange(B_HEADS)))).astype(np.float32)
    return {
        'x_prompt': nrm(ks[0], (BATCH, SEQ, D_MODEL), F32),
        'x_sample': nrm(ks[1], (DEC_BATCH, DEC_SEQ, D_MODEL), F32),
        'norm_g': 1.0 + 0.02 * nrm(ks[2], (DEPTH, D_MODEL), F32),
        'w_in_ab': nrm(ks[3], (N_EVEN, D_MODEL, AB_IN), F32) * (D_MODEL ** -0.5),
        'qk_norm_a': 1.0 + 0.02 * nrm(ks[4], (N_EVEN, 2, A_HEAD_DIM), F32),
        'ret_decay': jnp.asarray(base_decay) + 0.05 * nrm(ks[5], (N_EVEN, 2, B_HEADS), F32),
        'w_out_ab': nrm(ks[6], (N_EVEN, AB_OUT, D_MODEL), F32) * (AB_OUT ** -0.5),
        'w_in_c': nrm(ks[7], (N_ODD, D_MODEL, C_IN), F32) * (D_MODEL ** -0.5),
        'sink_c': 0.5 * nrm(ks[8], (N_ODD, C_HEADS), F32),
        'w_out_c': nrm(ks[9], (N_ODD, C_OUT, D_MODEL), F32) * (C_OUT ** -0.5),
        'rel_bias': 0.5 * nrm(ks[10], (REL_BUCKETS, C_HEADS), F32),
        'final_norm': 1.0 + 0.02 * nrm(ks[11], (D_MODEL,), F32),
    }


def reference(x_prompt, x_sample, norm_g, w_in_ab, qk_norm_a, ret_decay, w_out_ab, w_in_c, sink_c, w_out_c, rel_bias, final_norm):
    y_prompt = trunk(x_prompt, norm_g, w_in_ab, qk_norm_a, ret_decay, w_out_ab, w_in_c, sink_c, w_out_c, rel_bias, final_norm)
    y_sample = trunk(x_sample, norm_g, w_in_ab, qk_norm_a, ret_decay, w_out_ab, w_in_c, sink_c, w_out_c, rel_bias, final_norm)
    return (y_prompt, y_sample)
```

```cpp
#include <hip/hip_runtime.h>
#include <cstdio>
#include <cstdint>
#include <cmath>
namespace pg8 {
#define PG8_LAS __attribute__((address_space(3)))
typedef unsigned short bf16_t;
typedef short bf16x8 __attribute__((ext_vector_type(8)));
typedef float f32x4 __attribute__((ext_vector_type(4)));
typedef unsigned u32x4 __attribute__((ext_vector_type(4)));
constexpr int BM = 256, BK = 64, HALF = 128, HTB = HALF * BK * 2  , STAGE_BYTES = 8 * HTB, NXCD = 8, WGM = 8;

__host__ __device__ __forceinline__ int lds_byte(int r, int c) { const int st = (r >> 4) * 2 + (c >> 5), rr = r & 15, cc = c & 31, ob = rr * 64 + cc * 2; return st * 1024 + (ob ^ (((ob >> 9) & 1) << 5)); }
__host__ __device__ __forceinline__ void stage_rc(int b, int& R, int& C) { const int st = b / 1024, sb = b % 1024, swz = sb ^ (((sb >> 9) & 1) << 5); R = (st >> 1) * 16 + swz / 64; C = (st & 1) * 32 + (swz % 64) / 2; }
__host__ __device__ __forceinline__ int perm32(int rho) { const int n = rho >> 4, i = rho & 15; return 8 * (i >> 2) + 4 * n + (i & 3); }

struct Unit { int pm, pn; };
struct Gemm { const bf16_t* A; const bf16_t* Bt; int M, N, K, lda; };

struct StaticOrder {
    int nM, nN, nwg, G, c;
    __host__ __device__ void init(int M, int N, int G_, int c_) { nM = M / BM; nN = N / BM; nwg = nM * nN; G = G_; c = c_; }
    __host__ __device__ bool next(int i, Unit& u) const {
        const long L = (long)i * G + c; if (L >= nwg) return false;
        int wgid = (int)L; { const int q = nwg / NXCD, r = nwg % NXCD, xcd = wgid % NXCD, off = wgid / NXCD; wgid = (xcd < r ? xcd * (q + 1) : r * (q + 1) + (xcd - r) * q) + off; }
        const int nig = WGM * nN, gid = wgid / nig, fm = gid * WGM, gsz = (nM - fm) < WGM ? (nM - fm) : WGM;
        u.pm = fm + ((wgid % nig) % gsz); u.pn = (wgid % nig) / gsz; return true;
    }
    __device__ __forceinline__ void a_ready(const Unit&) const {}
    __device__ __forceinline__ void done(const Unit&) const {}
};

__device__ __forceinline__ unsigned cvt_pk_bf16(float lo, float hi) { unsigned r; asm volatile("v_cvt_pk_bf16_f32 %0, %1, %2" : "=v"(r) : "v"(lo), "v"(hi)); return r; }
template <class Epi, class Sched, bool ALIGN_EPI = false, bool SP2 = false>
__device__ __forceinline__ void gemm_phase(PG8_LAS unsigned char* lds, const Gemm g, const Sched& S, const Epi& E) {
    const int tid = threadIdx.x, wid = __builtin_amdgcn_readfirstlane(tid >> 6), lane = tid & 63, wr = wid >> 2, wc = wid & 3, fr = lane & 15, fq = lane >> 4;
    const int K = g.K, nt = K / BK;
    unsigned voffA[2], voffB[2];
#pragma unroll
    for (int i = 0; i < 2; ++i) { int R, C; stage_rc(tid * 16 + i * 8192, R, C); const int Rb = 64 * (R >> 5) + perm32(R & 31);
        voffA[i] = (unsigned)(R * g.lda + C) * 2u; voffB[i] = (unsigned)(Rb * K + C) * 2u; }
    const size_t kstep = (size_t)(BK * 2);
    const size_t hstepA = (size_t)HALF * g.lda * 2, tstepA = 2 * hstepA;
    const size_t hstepB = (size_t)32 * K * 2, tstepB = (size_t)BM * K * 2;
    const unsigned ldsw = (unsigned)wid * 1024u;
    const int aoff = lds_byte(wr * 64 + fr, fq * 8), boff = lds_byte(wc * 32 + fr, fq * 8);
#define PG8_SA(b, h) (((b) * 2 + (h)) * HTB)
#define PG8_SB(b, h) ((4 + (b) * 2 + (h)) * HTB)
#define PG8_STAGE(bufoff, gbase, voff) do { _Pragma("unroll") for (int _i = 0; _i < 2; ++_i) \
        __builtin_amdgcn_global_load_lds((const unsigned*)((const char*)(gbase) + (voff)[_i]), (PG8_LAS unsigned*)(lds + (bufoff) + ldsw + _i * 8192), 16, 0, 0); } while (0)
#define PG8_LDA(dst, b, h) do { _Pragma("unroll") for (int m = 0; m < 4; ++m) _Pragma("unroll") for (int k = 0; k < 2; ++k) dst[m][k] = *(const PG8_LAS bf16x8*)(lds + PG8_SA(b, h) + aoff + m * 2048 + k * 1024); } while (0)
#define PG8_LDB(dst, b, h) do { _Pragma("unroll") for (int n = 0; n < 2; ++n) _Pragma("unroll") for (int k = 0; k < 2; ++k) dst[n][k] = *(const PG8_LAS bf16x8*)(lds + PG8_SB(b, h) + boff + n * 2048 + k * 1024); } while (0)
#define PG8_MMA(ai, bj, At, Bt) do { __builtin_amdgcn_s_setprio(1); _Pragma("unroll") for (int m = 0; m < 4; ++m) _Pragma("unroll") for (int n = 0; n < 2; ++n) _Pragma("unroll") for (int k = 0; k < 2; ++k) \
        acc[ai][bj][m][n] = __builtin_amdgcn_mfma_f32_16x16x32_bf16(Bt[n][k], At[m][k], acc[ai][bj][m][n], 0, 0, 0); __builtin_amdgcn_s_setprio(0); } while (0)
#define PG8_WAIT_V(n) asm volatile("s_waitcnt vmcnt(" #n ")" ::: "memory")
#define PG8_WAIT_L(n) asm volatile("s_waitcnt lgkmcnt(" #n ")" ::: "memory")
#define PG8_BAR __builtin_amdgcn_s_barrier()
#define PG8_SCHED __builtin_amdgcn_sched_barrier(0)
    Unit cur, nxt; int ui = 0;
    if (!S.next(0, cur)) return;
    f32x4 acc[2][2][4][2];
#pragma unroll
    for (int a = 0; a < 2; ++a)
#pragma unroll
        for (int b = 0; b < 2; ++b)
#pragma unroll
            for (int m = 0; m < 4; ++m)
#pragma unroll
                for (int n = 0; n < 2; ++n) acc[a][b][m][n] = (f32x4){0.f, 0.f, 0.f, 0.f};
    bf16x8 At[4][2], B0[2][2], B1[2][2];
    const char* cA = (const char*)g.A + (size_t)cur.pm * tstepA; const char* cB = (const char*)g.Bt + (size_t)cur.pn * tstepB;
    S.a_ready(cur);
    if constexpr (SP2) {
        PG8_STAGE(PG8_SB(0, 0), cB, voffB); PG8_STAGE(PG8_SB(0, 1), cB + hstepB, voffB); PG8_STAGE(PG8_SA(0, 0), cA, voffA); PG8_STAGE(PG8_SA(0, 1), cA + hstepA, voffA);
        if (wr == 1) PG8_BAR;
        PG8_WAIT_V(2); PG8_BAR;
        PG8_STAGE(PG8_SB(1, 0), cB + kstep, voffB); PG8_STAGE(PG8_SA(1, 0), cA + kstep, voffA); PG8_STAGE(PG8_SB(1, 1), cB + hstepB + kstep, voffB);
        PG8_WAIT_V(6); PG8_BAR;
    } else {
        PG8_STAGE(PG8_SB(0, 0), cB, voffB); PG8_STAGE(PG8_SA(0, 0), cA, voffA); PG8_STAGE(PG8_SB(0, 1), cB + hstepB, voffB); PG8_STAGE(PG8_SA(0, 1), cA + hstepA, voffA);
        if (wr == 1) PG8_BAR;
        PG8_WAIT_V(4); PG8_BAR;
        PG8_STAGE(PG8_SB(1, 0), cB + kstep, voffB); PG8_STAGE(PG8_SA(1, 0), cA + kstep, voffA); PG8_STAGE(PG8_SB(1, 1), cB + hstepB + kstep, voffB);
        PG8_WAIT_V(6); PG8_BAR;
    }
    for (;;) {
        const bool has_next = S.next(ui + 1, nxt);
        const char* nA = has_next ? (const char*)g.A + (size_t)nxt.pm * tstepA : cA; const char* nB = has_next ? (const char*)g.Bt + (size_t)nxt.pn * tstepB : cB;
        for (int t = 0; t < nt; t += 2) {
            const bool last = (t == nt - 2);
            const char* a1 = cA + (size_t)(t + 1) * kstep;
            const char* a2 = last ? nA : cA + (size_t)(t + 2) * kstep; const char* b2 = last ? nB : cB + (size_t)(t + 2) * kstep;
            const char* a3 = a2 + kstep; const char* b3 = b2 + kstep;
            if (last && has_next) S.a_ready(nxt);
            if constexpr (SP2) {
            PG8_LDB(B0, 0, 0); PG8_LDB(B1, 0, 1); PG8_SCHED; PG8_LDA(At, 0, 0); PG8_STAGE(PG8_SA(1, 1), a1 + hstepA, voffA);
            PG8_WAIT_V(8); PG8_WAIT_L(0); PG8_BAR; PG8_MMA(0, 0, At, B0); PG8_MMA(0, 1, At, B1); PG8_BAR; PG8_SCHED;
            PG8_LDA(At, 0, 1); PG8_STAGE(PG8_SB(0, 0), b2, voffB); PG8_STAGE(PG8_SB(0, 1), b2 + hstepB, voffB); PG8_STAGE(PG8_SA(0, 0), a2, voffA);
            PG8_WAIT_V(8); PG8_WAIT_L(0); PG8_BAR; PG8_MMA(1, 0, At, B0); PG8_MMA(1, 1, At, B1); PG8_BAR; PG8_SCHED;
            PG8_LDB(B0, 1, 0); PG8_LDB(B1, 1, 1); PG8_SCHED; PG8_LDA(At, 1, 0); PG8_STAGE(PG8_SA(0, 1), a2 + hstepA, voffA);
            PG8_WAIT_V(8); PG8_WAIT_L(0); PG8_BAR; PG8_MMA(0, 0, At, B0); PG8_MMA(0, 1, At, B1); PG8_BAR; PG8_SCHED;
            PG8_LDA(At, 1, 1); PG8_STAGE(PG8_SB(1, 0), b3, voffB); PG8_STAGE(PG8_SB(1, 1), b3 + hstepB, voffB); PG8_STAGE(PG8_SA(1, 0), a3, voffA);
            PG8_WAIT_V(8); PG8_WAIT_L(0); PG8_BAR; PG8_MMA(1, 0, At, B0); PG8_MMA(1, 1, At, B1); PG8_BAR; PG8_SCHED;
            } else {
            PG8_LDB(B0, 0, 0); PG8_SCHED; PG8_LDA(At, 0, 0); PG8_STAGE(PG8_SA(1, 1), a1 + hstepA, voffA);
            PG8_WAIT_L(8); PG8_BAR; PG8_WAIT_L(0); PG8_MMA(0, 0, At, B0); PG8_BAR; PG8_SCHED;
            PG8_LDB(B1, 0, 1); PG8_STAGE(PG8_SB(0, 0), b2, voffB);
            PG8_BAR; PG8_WAIT_L(0); PG8_MMA(0, 1, At, B1); PG8_BAR;
            PG8_LDA(At, 0, 1); PG8_STAGE(PG8_SA(0, 0), a2, voffA);
            PG8_BAR; PG8_WAIT_L(0); PG8_MMA(1, 0, At, B0); PG8_BAR; PG8_SCHED;
            PG8_STAGE(PG8_SB(0, 1), b2 + hstepB, voffB);
            PG8_WAIT_V(6); PG8_BAR; PG8_MMA(1, 1, At, B1); PG8_BAR;
            PG8_LDB(B0, 1, 0); PG8_SCHED; PG8_LDA(At, 1, 0); PG8_STAGE(PG8_SA(0, 1), a2 + hstepA, voffA);
            PG8_WAIT_L(8); PG8_BAR; PG8_WAIT_L(0); PG8_MMA(0, 0, At, B0); PG8_BAR; PG8_SCHED;
            PG8_LDB(B1, 1, 1); PG8_STAGE(PG8_SB(1, 0), b3, voffB);
            PG8_BAR; PG8_WAIT_L(0); PG8_MMA(0, 1, At, B1); PG8_BAR;
            PG8_LDA(At, 1, 1); PG8_STAGE(PG8_SA(1, 0), a3, voffA);
            PG8_BAR; PG8_WAIT_L(0); PG8_MMA(1, 0, At, B0); PG8_BAR; PG8_SCHED;
            PG8_STAGE(PG8_SB(1, 1), b3 + hstepB, voffB);
            PG8_WAIT_V(6); PG8_BAR; PG8_MMA(1, 1, At, B1); PG8_BAR;
            }
        }
        if constexpr (ALIGN_EPI) { if (wr == 0) PG8_BAR; }
        if constexpr (!Epi::AFTER_DRAIN) { E(acc, cur, wr, wc, fr, fq); S.done(cur); }
        if (!has_next) break;
#pragma unroll
        for (int a = 0; a < 2; ++a)
#pragma unroll
            for (int b = 0; b < 2; ++b)
#pragma unroll
                for (int m = 0; m < 4; ++m)
#pragma unroll
                    for (int n = 0; n < 2; ++n) acc[a][b][m][n] = (f32x4){0.f, 0.f, 0.f, 0.f};
        cur = nxt; cA = nA; cB = nB; ++ui;
        if constexpr (ALIGN_EPI) { if (wr == 1) PG8_BAR; }
    }
    PG8_WAIT_V(0);
    if constexpr (!ALIGN_EPI) { if (wr == 0) PG8_BAR; }
    PG8_BAR;
    if constexpr (Epi::AFTER_DRAIN) { E.fused(acc, cur, wr, wc, fr, fq, lds, wid, lane); S.done(cur); }
#undef PG8_SA
#undef PG8_SB
#undef PG8_STAGE
#undef PG8_LDA
#undef PG8_LDB
#undef PG8_MMA
#undef PG8_WAIT_V
#undef PG8_WAIT_L
#undef PG8_BAR
#undef PG8_SCHED
}
}

constexpr int NWAVES = 8;
constexpr int DM = 1024, MROWS = 32768, MP = 16384;
constexpr int NAB = 2816, NCC = 2304;
constexpr float EPS = 1e-6f, LOG2E = 1.4426950408889634f, QSCALE = 0.125f * 1.4426950408889634f;
constexpr int ZA_Q = 0, ZA_K = 512, ZA_V = 640, ZB_Q = 768, ZB_K = 1024, ZB_V = 1280, ZA_G = 1792, ZB_G = 2304;
constexpr int ZC_Q = 0, ZC_K = 1024, ZC_V = 1152, ZC_G = 1280;

constexpr size_t MiB = 1u << 20;
constexpr size_t WS_CTL = 0, CTL_ZERO_BYTES = 64 * 1024;
constexpr size_t WS_AXT = 1 * MiB;
constexpr size_t WS_LINT = 1 * MiB + 65536;
constexpr size_t WS_PART1 = 3 * MiB, WS_PART2 = 5 * MiB;
constexpr size_t WS_WOAB = 7 * MiB, WS_WC = 9 * MiB, WS_WOC = 14 * MiB;
constexpr size_t WS_Z = 16 * MiB;
constexpr size_t WS_B = 192 * MiB;
constexpr size_t WS_END = 256 * MiB;
constexpr size_t OUT_XN = 0, OUT_WAB = 64 * MiB;

constexpr int CW_BAR = 1024;

constexpr int RING_OFF = 0, RING_BYTES = 131072;
constexpr int LDSCTL_OFF = RING_BYTES, MISC_OFF = LDSCTL_OFF + 320;
constexpr int LDS_BYTES = 147456;

#define GAS __attribute__((address_space(1)))
#define LAS __attribute__((address_space(3)))
typedef unsigned short bf16;
typedef unsigned v4u __attribute__((ext_vector_type(4)));
typedef float f32x4 __attribute__((ext_vector_type(4)));
typedef float f32x2 __attribute__((ext_vector_type(2)));
#define LDS_WAIT() asm volatile("s_waitcnt lgkmcnt(0)" ::: "memory")
#define VM_WAIT() asm volatile("s_waitcnt vmcnt(0)" ::: "memory")
__device__ __forceinline__ unsigned f2bf(float f) { unsigned u = __builtin_bit_cast(unsigned, f); return (u + 0x7fffu + ((u >> 16) & 1u)) >> 16; }
__device__ __forceinline__ unsigned pk2(float lo, float hi) { return f2bf(lo) | (f2bf(hi) << 16); }
__device__ __forceinline__ float bf_lo(unsigned w) { return __builtin_bit_cast(float, w << 16); }
__device__ __forceinline__ float bf_hi(unsigned w) { return __builtin_bit_cast(float, w & 0xffff0000u); }
__device__ __forceinline__ int seq_pos(int row) { return row < MP ? (row & 4095) : (row & 2047); }
__device__ __forceinline__ float silu_f(float v) { return v * __builtin_amdgcn_rcpf(1.f + __builtin_amdgcn_exp2f(-v * LOG2E)); }

#define XB_TMO      128
#define XB_XCNT(j)  (256  + 64 * (j))
#define XB_XSUB(j)  (1280 + 64 * (j))
#define XB_XGEN(j)  (2304 + 64 * (j))
#define XB_TOP      3328
#define XB_TOPGEN   3392
#define XCD_BAR_WORDS 3456
#define XB_SPIN_CAP (1u << 18)
__device__ __forceinline__ unsigned xb_ld(unsigned* p)              { return __hip_atomic_load(p, __ATOMIC_RELAXED, __HIP_MEMORY_SCOPE_AGENT); }
__device__ __forceinline__ unsigned xb_add(unsigned* p, unsigned v) { return __hip_atomic_fetch_add(p, v, __ATOMIC_RELAXED, __HIP_MEMORY_SCOPE_AGENT); }
__device__ __forceinline__ unsigned xb_xcc_id() { return (unsigned)__builtin_amdgcn_s_getreg((3 << 11) | 20) & 0xFu; }
#define XB_SPIN(cond, bar) do { unsigned _sp = 0; while (cond) { __builtin_amdgcn_s_sleep(1); \
    if ((++_sp & 255u) == 0u) { if (xb_ld(&(bar)[XB_TMO])) break; if (_sp > XB_SPIN_CAP) { atomicAdd(&(bar)[XB_TMO], 1u); break; } } } } while (0)
struct XcdBarrier { unsigned* bar; unsigned x; volatile LAS unsigned* st; };
__device__ __forceinline__ XcdBarrier xcd_barrier_post(unsigned* bar, volatile LAS unsigned* st) {
    XcdBarrier b; b.bar = bar; b.x = xb_xcc_id(); b.st = st;
    if (threadIdx.x == 0) (void)xb_add(&bar[XB_XCNT(b.x)], 1u);
    return b;
}
__device__ __forceinline__ void xcd_barrier_complete(unsigned* bar, unsigned x, unsigned& nloc, unsigned& nx) {
    const unsigned G = gridDim.x * gridDim.y * gridDim.z;
    unsigned sum, cnt, mine, sp = 0u;
    for (;;) {
        sum = 0u; cnt = 0u; mine = 0u;
#pragma unroll
        for (unsigned j = 0; j < 16; ++j) { const unsigned c = xb_ld(&bar[XB_XCNT(j)]); sum += c; cnt += (c > 0u) ? 1u : 0u; mine = (j == x) ? c : mine; }
        if (sum == G) break;
        __builtin_amdgcn_s_sleep(1);
        if ((++sp & 255u) == 0u) { if (xb_ld(&bar[XB_TMO])) break; if (sp > XB_SPIN_CAP) { atomicAdd(&bar[XB_TMO], 1u); break; } }
    }
    nloc = mine > 0u ? mine : 1u; nx = cnt > 0u ? cnt : 1u;
}
__device__ __forceinline__ void xcd_barrier(const XcdBarrier& b) {
    asm volatile("s_waitcnt vmcnt(0)" ::: "memory");
    __syncthreads();
    if (threadIdx.x == 0) {
        unsigned* bar = b.bar;
        __builtin_amdgcn_s_waitcnt(0);
        unsigned nloc = b.st[0], nx = b.st[1];
        if (nloc == 0u) { xcd_barrier_complete(bar, b.x, nloc, nx); b.st[0] = nloc; b.st[1] = nx; }
        const unsigned old = xb_add(&bar[XB_XSUB(b.x)], 1u);
        const unsigned gen = old / nloc;
        if (old + 1u == (gen + 1u) * nloc) {
            __builtin_amdgcn_fence(__ATOMIC_RELEASE, "agent");
            asm volatile("s_waitcnt vmcnt(0)" ::: "memory");
            const unsigned og = xb_add(&bar[XB_TOP], 1u);
            const unsigned tg = og / nx;
            if (og + 1u == (tg + 1u) * nx) xb_add(&bar[XB_TOPGEN], 1u);
            else XB_SPIN(xb_ld(&bar[XB_TOPGEN]) == tg, bar);
            __builtin_amdgcn_fence(__ATOMIC_ACQUIRE, "agent");
            xb_add(&bar[XB_XGEN(b.x)], 1u);
            asm volatile("s_waitcnt vmcnt(0)" ::: "memory");
        } else {
            XB_SPIN(xb_ld(&bar[XB_XGEN(b.x)]) == gen, bar);
            __builtin_amdgcn_fence(__ATOMIC_ACQUIRE, "agent");
            asm volatile("s_waitcnt vmcnt(0)" ::: "memory");
        }
    }
    __syncthreads();
}

using pg8::Unit; using pg8::cvt_pk_bf16;
__device__ __forceinline__ f32x4 rot4(f32x4 y, f32x4 cs) { return (f32x4){y.x * cs.x - y.y * cs.y, y.x * cs.y + y.y * cs.x, y.z * cs.z - y.w * cs.w, y.z * cs.w + y.w * cs.z}; }
__device__ __forceinline__ f32x4 silu4(f32x4 v) { return (f32x4){silu_f(v.x), silu_f(v.y), silu_f(v.z), silu_f(v.w)}; }
__device__ __forceinline__ v4u pack8(f32x4 a, f32x4 b) { v4u w; w.x = cvt_pk_bf16(a.x, a.y); w.y = cvt_pk_bf16(a.z, a.w); w.z = cvt_pk_bf16(b.x, b.y); w.w = cvt_pk_bf16(b.z, b.w); return w; }

struct EpiInAB {
    static constexpr bool AFTER_DRAIN = false;
    bf16* Z; const float* gain; const float* axtab; const float* lintab;
    __device__ __forceinline__ void operator()(const f32x4 (&acc)[2][2][4][2], const Unit& u, int wr, int wc, int fr, int fq) const {
        const int pn = u.pn;
        int kind;
        if (pn < 2) kind = 1; else if (pn == 2) kind = (wc < 2) ? 2 : 0; else if (pn == 3) kind = 3; else if (pn == 4) kind = 4; else if (pn < 7) kind = 0; else kind = 5;
        const int colw = pn * 256 + wc * 64 + fq * 8;
        f32x4 gv[2][2];
        if (kind == 1 || kind == 2) {
            const float* gp = gain + (kind == 2 ? 64 : 0);
#pragma unroll
            for (int bj = 0; bj < 2; ++bj)
#pragma unroll
                for (int n = 0; n < 2; ++n) gv[bj][n] = *(const f32x4*)(gp + bj * 32 + fq * 8 + n * 4);
        }
#pragma unroll
        for (int ai = 0; ai < 2; ++ai)
#pragma unroll
            for (int m = 0; m < 4; ++m) {
                const int row = u.pm * 256 + ai * 128 + wr * 64 + m * 16 + fr; const int t = seq_pos(row);
                f32x4 v[2][2];
#pragma unroll
                for (int bj = 0; bj < 2; ++bj)
#pragma unroll
                    for (int n = 0; n < 2; ++n) v[bj][n] = acc[ai][bj][m][n];
                if (kind == 1 || kind == 2) {
                    float ss = 0.f;
#pragma unroll
                    for (int bj = 0; bj < 2; ++bj)
#pragma unroll
                        for (int n = 0; n < 2; ++n) { const f32x4 x = v[bj][n]; ss += (x.x * x.x + x.y * x.y) + (x.z * x.z + x.w * x.w); }
                    ss += __shfl_xor(ss, 16); ss += __shfl_xor(ss, 32);
                    const float rinv = rsqrtf(ss * (1.f / 64.f) + EPS) ;
                    const float sc = (kind == 1) ? QSCALE : 1.f;
#pragma unroll
                    for (int bj = 0; bj < 2; ++bj) { const int pos = bj == 0 ? (t >> 6) : (t & 63);
#pragma unroll
                        for (int n = 0; n < 2; ++n) { const f32x4 cs = *(const f32x4*)(axtab + (pos * 16 + 4 * fq + 2 * n) * 2);
                            v[bj][n] = rot4(v[bj][n] * rinv * gv[bj][n], cs) * sc; } }
                } else if (kind == 3 || kind == 4) {
                    const float sc = (kind == 4) ? 0.125f : 1.f;
#pragma unroll
                    for (int bj = 0; bj < 2; ++bj)
#pragma unroll
                        for (int n = 0; n < 2; ++n) { const f32x4 cs = *(const f32x4*)(lintab + ((size_t)t * 32 + 16 * bj + 4 * fq + 2 * n) * 2);
                            v[bj][n] = rot4(v[bj][n], cs) * sc; }
                } else if (kind == 5) {
#pragma unroll
                    for (int bj = 0; bj < 2; ++bj)
#pragma unroll
                        for (int n = 0; n < 2; ++n) v[bj][n] = silu4(v[bj][n]);
                }
                bf16* rowp = Z + (size_t)row * NAB + colw;
#pragma unroll
                for (int bj = 0; bj < 2; ++bj) *(v4u*)(rowp + bj * 32) = pack8(v[bj][0], v[bj][1]);
            }
    }
};
struct EpiOut {
    static constexpr bool AFTER_DRAIN = false;
    const float* base0; const float* base1;
    float* out; bf16* xbf; float* part;
    __device__ __forceinline__ void operator()(const f32x4 (&acc)[2][2][4][2], const Unit& u, int wr, int wc, int fr, int fq) const {
        const int colw = u.pn * 256 + wc * 64 + fq * 8;
#pragma unroll
        for (int ai = 0; ai < 2; ++ai)
#pragma unroll
            for (int m = 0; m < 4; ++m) {
                const int row = u.pm * 256 + ai * 128 + wr * 64 + m * 16 + fr;
                const float* bp = (row < MP ? base0 + (size_t)row * DM : base1 + (size_t)(row - MP) * DM) + colw;
                float* op = out + (size_t)row * DM + colw;
                float ss = 0.f; f32x4 o[2][2];
#pragma unroll
                for (int bj = 0; bj < 2; ++bj)
#pragma unroll
                    for (int n = 0; n < 2; ++n) { const f32x4 b = *(const f32x4*)(bp + bj * 32 + n * 4); const f32x4 x = b + acc[ai][bj][m][n]; o[bj][n] = x;
                        ss += (x.x * x.x + x.y * x.y) + (x.z * x.z + x.w * x.w); }
#pragma unroll
                for (int bj = 0; bj < 2; ++bj)
#pragma unroll
                    for (int n = 0; n < 2; ++n) *(f32x4*)(op + bj * 32 + n * 4) = o[bj][n];
                if (xbf) {
#pragma unroll
                    for (int bj = 0; bj < 2; ++bj) *(v4u*)(xbf + (size_t)row * DM + colw + bj * 32) = pack8(o[bj][0], o[bj][1]);
                }
                ss += __shfl_xor(ss, 16); ss += __shfl_xor(ss, 32);
                if (fq == 0) part[(size_t)row * 16 + u.pn * 4 + wc] = ss;
            }
    }
};
struct EpiInC {
    static constexpr bool AFTER_DRAIN = false;
    bf16* Z; const float* part;
    __device__ __forceinline__ void operator()(const f32x4 (&acc)[2][2][4][2], const Unit& u, int wr, int wc, int fr, int fq) const {
        const int pn = u.pn; const int kind = pn < 4 ? 1 : (pn == 4 ? 0 : 5);
        const int colw = pn * 256 + wc * 64 + fq * 8;
#pragma unroll
        for (int ai = 0; ai < 2; ++ai)
#pragma unroll
            for (int m = 0; m < 4; ++m) {
                const int row = u.pm * 256 + ai * 128 + wr * 64 + m * 16 + fr;
                const f32x4* pp = (const f32x4*)(part + (size_t)row * 16);
                const f32x4 p0 = pp[0], p1 = pp[1], p2 = pp[2], p3 = pp[3];
                const float s = ((p0.x + p0.y) + (p0.z + p0.w)) + ((p1.x + p1.y) + (p1.z + p1.w)) + ((p2.x + p2.y) + (p2.z + p2.w)) + ((p3.x + p3.y) + (p3.z + p3.w));
                float rstd = rsqrtf(s * (1.f / DM) + EPS); if (kind == 1) rstd *= QSCALE;
                bf16* rowp = Z + (size_t)row * NCC + colw;
#pragma unroll
                for (int bj = 0; bj < 2; ++bj) { f32x4 a = acc[ai][bj][m][0] * rstd, b = acc[ai][bj][m][1] * rstd;
                    if (kind == 5) { a = silu4(a); b = silu4(b); }
                    *(v4u*)(rowp + bj * 32) = pack8(a, b); }
            }
    }
};

struct Frame {
    LAS unsigned char* lds;
    volatile LAS unsigned* MISC;
    int tid, lane, wave, vcu, G;
};
__device__ __forceinline__ float wave_sum(float v) {
#pragma unroll
    for (int o = 1; o < 64; o <<= 1) v += __shfl_xor(v, o);
    return v;
}
__device__ __forceinline__ int remap_ab(int n0) { return n0 < 768 ? n0 : (n0 < 1280 ? n0 + 1024 : (n0 < 2304 ? n0 - 512 : n0)); }
__device__ __forceinline__ void p0_transpose_item(const float* W, int K, int N, const float* g, bool remap, bf16* WT, LAS float* scr, int item, int lane) {
    const int nblk = N / 32, kb = item / nblk, nb = item % nblk, k0 = 64 * kb, n0 = 32 * nb;
    const int d0 = remap ? remap_ab(n0) : n0;
#pragma unroll 8
    for (int i = 0; i < 32; ++i) { const int kk = 2 * i + (lane >> 5); const float gs = g ? g[k0 + kk] : 1.f; scr[kk * 33 + (lane & 31)] = W[(size_t)(k0 + kk) * N + n0 + (lane & 31)] * gs; }
    LDS_WAIT(); asm volatile("" ::: "memory");
    const int c = lane & 7;
#pragma unroll
    for (int j = 0; j < 4; ++j) { const int n = (lane >> 3) + 8 * j; const LAS float* s = scr + (8 * c) * 33 + n;
        v4u o; o.x = pk2(s[0 * 33], s[1 * 33]); o.y = pk2(s[2 * 33], s[3 * 33]); o.z = pk2(s[4 * 33], s[5 * 33]); o.w = pk2(s[6 * 33], s[7 * 33]);
        *(GAS v4u*)(WT + (size_t)(d0 + n) * K + k0 + 8 * c) = o; }
    LDS_WAIT(); asm volatile("" ::: "memory");
}
__device__ __forceinline__ void rms_row_to_bf16(int lane, const float* xrow, bf16* orow) {
    const GAS f32x4* xr = (const GAS f32x4*)xrow + lane;
    f32x4 v[4]; float s = 0.f;
#pragma unroll
    for (int j = 0; j < 4; ++j) { v[j] = xr[64 * j]; s += (v[j].x * v[j].x + v[j].y * v[j].y) + (v[j].z * v[j].z + v[j].w * v[j].w); }
    const float rstd = rsqrtf(wave_sum(s) * (1.f / DM) + EPS);
    GAS unsigned long long* o8 = (GAS unsigned long long*)orow + lane;
#pragma unroll
    for (int j = 0; j < 4; ++j) o8[64 * j] = (unsigned long long)pk2(v[j].x * rstd, v[j].y * rstd) | ((unsigned long long)pk2(v[j].z * rstd, v[j].w * rstd) << 32);
}

__device__ __forceinline__ int t5_bucket(int rel) {
    const int d = rel < 0 ? -rel : rel; int b;
    if (d < 8) b = d; else if (d < 12) b = 8; else if (d < 16) b = 9; else if (d < 23) b = 10; else if (d < 32) b = 11; else if (d < 46) b = 12; else if (d < 64) b = 13; else if (d < 91) b = 14; else b = 15;
    return b + (rel > 0 ? 16 : 0);
}
template <int MODE> __device__ __forceinline__ void sc_attn_item(Frame& F, bf16* Z, int item, const float* sink, const float* rel_bias) {
    constexpr int LD = MODE == 0 ? NAB : NCC;
    const int h = item >> 6, bq = item & 63, row0 = bq * 512;
    const int sbase = row0 < MP ? (row0 & ~4095) : (MP + ((row0 - MP) & ~2047)), slen = row0 < MP ? 4096 : 2048;
    const int qcol = (MODE == 0 ? ZA_Q : ZC_Q) + h * 64, kcol = MODE == 0 ? ZA_K + (h >> 2) * 64 : ZC_K + (h >> 3) * 64, vcol = MODE == 0 ? ZA_V + (h >> 2) * 64 : ZC_V + (h >> 3) * 64;
    const int gcol = (MODE == 0 ? ZA_G : ZC_G) + h * 64;
    LAS float* Kt = (LAS float*)(F.lds + RING_OFF); LAS float* Vt = Kt + 64 * 64; LAS float* tab = Vt + 64 * 64;
    const int row = row0 + F.tid, ipos = row - sbase;
    float q[64], o[64];
    { const v4u* qp = (const v4u*)(Z + (size_t)row * LD + qcol);
#pragma unroll
      for (int c = 0; c < 8; ++c) { const v4u w = qp[c]; q[8 * c + 0] = bf_lo(w.x); q[8 * c + 1] = bf_hi(w.x); q[8 * c + 2] = bf_lo(w.y); q[8 * c + 3] = bf_hi(w.y); q[8 * c + 4] = bf_lo(w.z); q[8 * c + 5] = bf_hi(w.z); q[8 * c + 6] = bf_lo(w.w); q[8 * c + 7] = bf_hi(w.w); } }
#pragma unroll
    for (int d = 0; d < 64; ++d) o[d] = 0.f;
    float mrun = -1e30f, lrun = 0.f;
    int k_lo = 0, k_hi = slen;
    if (MODE == 1) {
        __syncthreads();
        if (F.tid < 257) tab[F.tid] = rel_bias[t5_bucket(F.tid - 128) * 16 + h] * LOG2E;
        mrun = sink[h] * LOG2E; lrun = 1.f;
        const int p0 = row0 - sbase; k_lo = p0 - 128 < 0 ? 0 : p0 - 128; k_hi = p0 + 512 + 128 > slen ? slen : p0 + 512 + 128;
    }
    for (int k0 = k_lo; k0 < k_hi; k0 += 64) {
        __syncthreads();
        { const int key = F.tid >> 3, ch = F.tid & 7; const bf16* rp = Z + (size_t)(sbase + k0 + key) * LD;
          const v4u kw = *(const v4u*)(rp + kcol + ch * 8), vw = *(const v4u*)(rp + vcol + ch * 8);
          LAS float* kd = Kt + key * 64 + ch * 8; LAS float* vd = Vt + key * 64 + ch * 8;
          kd[0] = bf_lo(kw.x); kd[1] = bf_hi(kw.x); kd[2] = bf_lo(kw.y); kd[3] = bf_hi(kw.y); kd[4] = bf_lo(kw.z); kd[5] = bf_hi(kw.z); kd[6] = bf_lo(kw.w); kd[7] = bf_hi(kw.w);
          vd[0] = bf_lo(vw.x); vd[1] = bf_hi(vw.x); vd[2] = bf_lo(vw.y); vd[3] = bf_hi(vw.y); vd[4] = bf_lo(vw.z); vd[5] = bf_hi(vw.z); vd[6] = bf_lo(vw.w); vd[7] = bf_hi(vw.w); }
        __syncthreads();
        for (int j = 0; j < 64; ++j) {
            const int rel = k0 + j - ipos;
            if (MODE == 1 && (rel > 128 || rel < -128)) continue;
            const LAS f32x4* kr = (const LAS f32x4*)(Kt + j * 64);
            float s0 = 0.f, s1 = 0.f, s2 = 0.f, s3 = 0.f;
#pragma unroll
            for (int c = 0; c < 16; ++c) { const f32x4 kv = kr[c]; s0 += q[4 * c] * kv.x; s1 += q[4 * c + 1] * kv.y; s2 += q[4 * c + 2] * kv.z; s3 += q[4 * c + 3] * kv.w; }
            float s = (s0 + s1) + (s2 + s3);
            if (MODE == 1) s += tab[rel + 128];
            const float mn = fmaxf(mrun, s), al = __builtin_amdgcn_exp2f(mrun - mn), p = __builtin_amdgcn_exp2f(s - mn);
            mrun = mn; lrun = lrun * al + p;
            const LAS f32x4* vr = (const LAS f32x4*)(Vt + j * 64);
#pragma unroll
            for (int c = 0; c < 16; ++c) { const f32x4 vv = vr[c]; o[4 * c] = o[4 * c] * al + p * vv.x; o[4 * c + 1] = o[4 * c + 1] * al + p * vv.y; o[4 * c + 2] = o[4 * c + 2] * al + p * vv.z; o[4 * c + 3] = o[4 * c + 3] * al + p * vv.w; }
        }
    }
    const float il = 1.f / lrun;
    v4u* gp = (v4u*)(Z + (size_t)row * LD + gcol);
#pragma unroll
    for (int c = 0; c < 8; ++c) { const v4u g = gp[c]; v4u w;
        w.x = pk2(o[8 * c + 0] * il * bf_lo(g.x), o[8 * c + 1] * il * bf_hi(g.x)); w.y = pk2(o[8 * c + 2] * il * bf_lo(g.y), o[8 * c + 3] * il * bf_hi(g.y));
        w.z = pk2(o[8 * c + 4] * il * bf_lo(g.z), o[8 * c + 5] * il * bf_hi(g.z)); w.w = pk2(o[8 * c + 6] * il * bf_lo(g.w), o[8 * c + 7] * il * bf_hi(g.w)); gp[c] = w; }
}
__device__ __forceinline__ void sc_ret_item(Frame& F, bf16* Z, int item, const float* ret_decay) {
    const int h = item >> 7, bq = item & 127, row0 = bq * 256;
    const int sbase = row0 < MP ? (row0 & ~4095) : (MP + ((row0 - MP) & ~2047)), slen = row0 < MP ? 4096 : 2048;
    const int qcol = ZB_Q + h * 64, kcol = ZB_K + h * 64, vcol = ZB_V + h * 128, gcol = ZB_G + h * 128;
    LAS float* Kt = (LAS float*)(F.lds + RING_OFF); LAS float* Vt = Kt + 64 * 64;
    const int row = row0 + (F.tid >> 1), half = F.tid & 1, ipos = row - sbase;
    const float lgf = -__expf(ret_decay[h]) * LOG2E, lgb = -__expf(ret_decay[4 + h]) * LOG2E;
    float q[64], o[64];
    { const v4u* qp = (const v4u*)(Z + (size_t)row * NAB + qcol);
#pragma unroll
      for (int c = 0; c < 8; ++c) { const v4u w = qp[c]; q[8 * c + 0] = bf_lo(w.x); q[8 * c + 1] = bf_hi(w.x); q[8 * c + 2] = bf_lo(w.y); q[8 * c + 3] = bf_hi(w.y); q[8 * c + 4] = bf_lo(w.z); q[8 * c + 5] = bf_hi(w.z); q[8 * c + 6] = bf_lo(w.w); q[8 * c + 7] = bf_hi(w.w); } }
#pragma unroll
    for (int d = 0; d < 64; ++d) o[d] = 0.f;
    for (int k0 = 0; k0 < slen; k0 += 64) {
        __syncthreads();
        { const int key = F.tid >> 3, ch = F.tid & 7; const bf16* rp = Z + (size_t)(sbase + k0 + key) * NAB;
          const v4u kw = *(const v4u*)(rp + kcol + ch * 8), vw = *(const v4u*)(rp + vcol + ch * 8), vw2 = *(const v4u*)(rp + vcol + 64 + ch * 8);
          LAS float* kd = Kt + key * 64 + ch * 8; LAS float* vd = Vt + key * 128 + ch * 8; LAS float* vd2 = vd + 64;
          kd[0] = bf_lo(kw.x); kd[1] = bf_hi(kw.x); kd[2] = bf_lo(kw.y); kd[3] = bf_hi(kw.y); kd[4] = bf_lo(kw.z); kd[5] = bf_hi(kw.z); kd[6] = bf_lo(kw.w); kd[7] = bf_hi(kw.w);
          vd[0] = bf_lo(vw.x); vd[1] = bf_hi(vw.x); vd[2] = bf_lo(vw.y); vd[3] = bf_hi(vw.y); vd[4] = bf_lo(vw.z); vd[5] = bf_hi(vw.z); vd[6] = bf_lo(vw.w); vd[7] = bf_hi(vw.w);
          vd2[0] = bf_lo(vw2.x); vd2[1] = bf_hi(vw2.x); vd2[2] = bf_lo(vw2.y); vd2[3] = bf_hi(vw2.y); vd2[4] = bf_lo(vw2.z); vd2[5] = bf_hi(vw2.z); vd2[6] = bf_lo(vw2.w); vd2[7] = bf_hi(vw2.w); }
        __syncthreads();
        for (int j = 0; j < 64; ++j) {
            const int d = ipos - (k0 + j);
            const float w = d >= 0 ? __builtin_amdgcn_exp2f(lgf * (float)d) : __builtin_amdgcn_exp2f(lgb * (float)(-d));
            const LAS f32x4* kr = (const LAS f32x4*)(Kt + j * 64);
            float s0 = 0.f, s1 = 0.f, s2 = 0.f, s3 = 0.f;
#pragma unroll
            for (int c = 0; c < 16; ++c) { const f32x4 kv = kr[c]; s0 += q[4 * c] * kv.x; s1 += q[4 * c + 1] * kv.y; s2 += q[4 * c + 2] * kv.z; s3 += q[4 * c + 3] * kv.w; }
            const float s = ((s0 + s1) + (s2 + s3)) * w;
            const LAS f32x4* vr = (const LAS f32x4*)(Vt + j * 128 + half * 64);
#pragma unroll
            for (int c = 0; c < 16; ++c) { const f32x4 vv = vr[c]; o[4 * c] += s * vv.x; o[4 * c + 1] += s * vv.y; o[4 * c + 2] += s * vv.z; o[4 * c + 3] += s * vv.w; }
        }
    }
    float ss = 0.f;
#pragma unroll
    for (int d = 0; d < 64; ++d) ss += o[d] * o[d];
    ss += __shfl_xor(ss, 1);
    const float r = rsqrtf(ss * (1.f / 128.f) + EPS);
    v4u* gp = (v4u*)(Z + (size_t)row * NAB + gcol + half * 64);
#pragma unroll
    for (int c = 0; c < 8; ++c) { const v4u g = gp[c]; v4u w;
        w.x = pk2(o[8 * c + 0] * r * bf_lo(g.x), o[8 * c + 1] * r * bf_hi(g.x)); w.y = pk2(o[8 * c + 2] * r * bf_lo(g.y), o[8 * c + 3] * r * bf_hi(g.y));
        w.z = pk2(o[8 * c + 4] * r * bf_lo(g.z), o[8 * c + 5] * r * bf_hi(g.z)); w.w = pk2(o[8 * c + 6] * r * bf_lo(g.w), o[8 * c + 7] * r * bf_hi(g.w)); gp[c] = w; }
}

#ifndef MK_N_LAUNCHES
#define MK_N_LAUNCHES 9
#endif
constexpr int N_PHASES = 9;
struct Args { const float* in[12]; float* out; unsigned char* ws; int ph_lo, ph_hi; };
__global__ void __launch_bounds__(NWAVES * 64, 2) mk_fwd(Args args) {
    extern __shared__ __attribute__((aligned(16))) unsigned char lds[];
    Frame F;
    F.lds = (LAS unsigned char*)lds;
    F.MISC = (volatile LAS unsigned*)(F.lds + MISC_OFF);
    F.tid = threadIdx.x; F.lane = F.tid & 63; F.wave = __builtin_amdgcn_readfirstlane(F.tid >> 6);
    F.G = gridDim.x; { const int bx = blockIdx.x; F.vcu = (F.G % 8 == 0) ? (bx % 8) * (F.G / 8) + bx / 8 : bx; }
    unsigned char* ws = args.ws;
    unsigned* ctl = (unsigned*)(ws + WS_CTL);
    const float* x_prompt = args.in[0]; const float* x_sample = args.in[1]; const float* norm_g = args.in[2]; const float* w_in_ab = args.in[3];
    const float* qk_norm = args.in[4]; const float* ret_decay = args.in[5]; const float* w_out_ab = args.in[6]; const float* w_in_c = args.in[7];
    const float* sink_c = args.in[8]; const float* w_out_c = args.in[9]; const float* rel_bias = args.in[10]; const float* final_norm = args.in[11];
    float* out = args.out;
    bf16* XN0 = (bf16*)((unsigned char*)out + OUT_XN); bf16* WAB = (bf16*)((unsigned char*)out + OUT_WAB);
    bf16* WOAB = (bf16*)(ws + WS_WOAB); bf16* WC = (bf16*)(ws + WS_WC); bf16* WOC = (bf16*)(ws + WS_WOC);
    bf16* Z = (bf16*)(ws + WS_Z); bf16* X1B = (bf16*)(ws + WS_B);
    float* AXT = (float*)(ws + WS_AXT); float* LINT = (float*)(ws + WS_LINT); float* PART1 = (float*)(ws + WS_PART1); float* PART2 = (float*)(ws + WS_PART2);

    for (int u = F.tid; u < (LDS_BYTES - LDSCTL_OFF) / 4; u += NWAVES * 64) ((LAS unsigned*)(F.lds + LDSCTL_OFF))[u] = 0u;
    __syncthreads();
    const int lo = args.ph_lo, hi = args.ph_hi;
    XcdBarrier bar; bar.bar = ctl + CW_BAR; bar.x = 0; bar.st = nullptr;
    if (hi - lo > 1) bar = xcd_barrier_post(ctl + CW_BAR, F.MISC + 8);
#define IN(k) (lo <= (k) && (k) < hi)
#define SEAM(k) do { if (IN(k) && IN((k) + 1)) xcd_barrier(bar); } while (0)

    if (IN(0)) {
        LAS float* scr = (LAS float*)(F.lds + RING_OFF + F.wave * 16384);
        const int gw = F.vcu * NWAVES + F.wave, NGW = F.G * NWAVES;
        constexpr int I_AB = 16 * (NAB / 32), I_O = 16 * 32, I_C = 16 * (NCC / 32);
        constexpr int NITEMS = I_AB + I_O + I_C + I_O;
        for (int it = gw; it < NITEMS; it += NGW) {
            int r = it;
            if (r < I_AB) { p0_transpose_item(w_in_ab, DM, NAB, norm_g, true, WAB, scr, r, F.lane); continue; } r -= I_AB;
            if (r < I_O) { p0_transpose_item(w_out_ab, DM, DM, nullptr, false, WOAB, scr, r, F.lane); continue; } r -= I_O;
            if (r < I_C) { p0_transpose_item(w_in_c, DM, NCC, norm_g + DM, false, WC, scr, r, F.lane); continue; } r -= I_C;
            p0_transpose_item(w_out_c, DM, DM, nullptr, false, WOC, scr, r, F.lane);
        }
        for (int m = gw; m < MROWS; m += NGW) rms_row_to_bf16(F.lane, m < MP ? x_prompt + (size_t)m * DM : x_sample + (size_t)(m - MP) * DM, XN0 + (size_t)m * DM);
        const int gt = blockIdx.x * (NWAVES * 64) + F.tid, NGT = F.G * NWAVES * 64;
        for (int e = gt; e < 64 * 16 + 4096 * 32; e += NGT) {
            double ang; float* dst;
            if (e < 1024) { const int pos = e >> 4, j = e & 15; ang = (double)pos * pow(10000.0, -(double)j / 16.0); dst = AXT + 2 * e; }
            else { const int e2 = e - 1024, t = e2 >> 5, j = e2 & 31; ang = (double)t * pow(10000.0, -(double)j / 32.0); dst = LINT + 2 * e2; }
            dst[0] = (float)cos(ang); dst[1] = (float)sin(ang);
        }
    }
    SEAM(0);
    if (IN(1)) {
        pg8::Gemm g{XN0, WAB, MROWS, NAB, DM, DM}; pg8::StaticOrder S; S.init(MROWS, NAB, F.G, (int)blockIdx.x);
        EpiInAB E{Z, qk_norm, AXT, LINT};
        pg8::gemm_phase<EpiInAB, pg8::StaticOrder, true, true>(F.lds + RING_OFF, g, S, E);
    }
    SEAM(1);
    if (IN(2)) {
        for (int it = blockIdx.x; it < 512 + 512; it += F.G) {
            if (it < 512) sc_attn_item<0>(F, Z, it, nullptr, nullptr); else sc_ret_item(F, Z, it - 512, ret_decay);
        }
        __syncthreads();
    }
    SEAM(3);
    if (IN(4)) {
        pg8::Gemm g{Z + ZA_G, WOAB, MROWS, DM, DM, NAB}; pg8::StaticOrder S; S.init(MROWS, DM, F.G, (int)blockIdx.x);
        EpiOut E{x_prompt, x_sample, out, X1B, PART1};
        pg8::gemm_phase<EpiOut, pg8::StaticOrder, true, true>(F.lds + RING_OFF, g, S, E);
    }
    SEAM(4);
    if (IN(5)) {
        pg8::Gemm g{X1B, WC, MROWS, NCC, DM, DM}; pg8::StaticOrder S; S.init(MROWS, NCC, F.G, (int)blockIdx.x);
        EpiInC E{Z, PART1};
        pg8::gemm_phase<EpiInC, pg8::StaticOrder, true, true>(F.lds + RING_OFF, g, S, E);
    }
    SEAM(5);
    if (IN(6)) {
        for (int it = blockIdx.x; it < 1024; it += F.G) sc_attn_item<1>(F, Z, it, sink_c, rel_bias);
        __syncthreads();
    }
    SEAM(6);
    if (IN(7)) {
        pg8::Gemm g{Z + ZC_G, WOC, MROWS, DM, DM, NCC}; pg8::StaticOrder S; S.init(MROWS, DM, F.G, (int)blockIdx.x);
        EpiOut E{out, out + (size_t)MP * DM, out, nullptr, PART2};
        pg8::gemm_phase<EpiOut, pg8::StaticOrder, true, true>(F.lds + RING_OFF, g, S, E);
    }
    SEAM(7);
    if (IN(8)) {
        const int gw = F.vcu * NWAVES + F.wave, NGW = F.G * NWAVES;
        for (int m = gw; m < MROWS; m += NGW) {
            const f32x4* pp = (const f32x4*)(PART2 + (size_t)m * 16);
            const f32x4 p0 = pp[0], p1 = pp[1], p2 = pp[2], p3 = pp[3];
            const float s = ((p0.x + p0.y) + (p0.z + p0.w)) + ((p1.x + p1.y) + (p1.z + p1.w)) + ((p2.x + p2.y) + (p2.z + p2.w)) + ((p3.x + p3.y) + (p3.z + p3.w));
            const float rstd = rsqrtf(s * (1.f / DM) + EPS);
            f32x4* xr = (f32x4*)(out + (size_t)m * DM) + F.lane; const f32x4* gr = (const f32x4*)final_norm + F.lane;
#pragma unroll
            for (int j = 0; j < 4; ++j) xr[64 * j] = xr[64 * j] * rstd * gr[64 * j];
        }
    }
#undef IN
#undef SEAM
}

extern "C" void kernel_launch(void* const* d_in, const int* in_sizes, int n_in, void* d_out, int out_size, void* d_ws, size_t ws_size, hipStream_t stream) {
    static int grid = 0;
    if (grid == 0) {
        if (n_in != 12 || out_size != MROWS * DM || ws_size < WS_END) { fprintf(stderr, "kernel_launch: unexpected shapes (n_in %d, out %d, ws %zu)\n", n_in, out_size, ws_size); grid = -1; return; }
        int dev = 0, cus = 0, per_cu = 0;
        if (hipGetDevice(&dev) != hipSuccess || hipDeviceGetAttribute(&cus, hipDeviceAttributeMultiprocessorCount, dev) != hipSuccess) { grid = -1; return; }
        if (hipFuncSetAttribute((const void*)mk_fwd, hipFuncAttributeMaxDynamicSharedMemorySize, LDS_BYTES) != hipSuccess) { fprintf(stderr, "kernel_launch: hipFuncSetAttribute failed\n"); grid = -1; return; }
        if (hipOccupancyMaxActiveBlocksPerMultiprocessor(&per_cu, (const void*)mk_fwd, NWAVES * 64, LDS_BYTES) != hipSuccess || per_cu < 1) { fprintf(stderr, "kernel_launch: occupancy query says %d blocks per CU\n", per_cu); grid = -1; (void)hipGetLastError(); return; }
        grid = cus;
    }
    if (grid < 0) return;
    (void)hipMemsetAsync((char*)d_ws + WS_CTL, 0, CTL_ZERO_BYTES, stream);
    Args a{};
    for (int i = 0; i < 12; ++i) a.in[i] = (const float*)d_in[i];
    a.out = (float*)d_out; a.ws = (unsigned char*)d_ws;
#if MK_N_LAUNCHES == 1
    a.ph_lo = 0; a.ph_hi = N_PHASES;
    void* kargs[] = {&a};
    hipError_t e = hipLaunchCooperativeKernel((const void*)mk_fwd, dim3(grid), dim3(NWAVES * 64), kargs, LDS_BYTES, stream);
    if (e != hipSuccess) fprintf(stderr, "kernel_launch: cooperative launch failed: %s\n", hipGetErrorString(e));
#else
    for (int p = 0; p < N_PHASES; ++p) { if (p == 3) continue; a.ph_lo = p; a.ph_hi = p + 1; hipLaunchKernelGGL(mk_fwd, dim3(grid), dim3(NWAVES * 64), LDS_BYTES, stream, a); }
#endif
}
```

```cpp
#include <hip/hip_runtime.h>
#include <cstdio>
#include <cstdint>
#include <cmath>
namespace pg8 {
#define PG8_LAS __attribute__((address_space(3)))
typedef unsigned short bf16_t;
typedef short bf16x8 __attribute__((ext_vector_type(8)));
typedef float f32x4 __attribute__((ext_vector_type(4)));
typedef unsigned u32x4 __attribute__((ext_vector_type(4)));
constexpr int BM = 256, BK = 64, HALF = 128, HTB = HALF * BK * 2  , STAGE_BYTES = 8 * HTB, NXCD = 8, WGM = 8;

__host__ __device__ __forceinline__ int lds_byte(int r, int c) { const int st = (r >> 4) * 2 + (c >> 5), rr = r & 15, cc = c & 31, ob = rr * 64 + cc * 2; return st * 1024 + (ob ^ (((ob >> 9) & 1) << 5)); }
__host__ __device__ __forceinline__ void stage_rc(int b, int& R, int& C) { const int st = b / 1024, sb = b % 1024, swz = sb ^ (((sb >> 9) & 1) << 5); R = (st >> 1) * 16 + swz / 64; C = (st & 1) * 32 + (swz % 64) / 2; }
__host__ __device__ __forceinline__ int perm32(int rho) { const int n = rho >> 4, i = rho & 15; return 8 * (i >> 2) + 4 * n + (i & 3); }

struct Unit { int pm, pn; };
struct Gemm { const bf16_t* A; const bf16_t* Bt; int M, N, K, lda; };

struct StaticOrder {
    int nM, nN, nwg, G, c;
    __host__ __device__ void init(int M, int N, int G_, int c_) { nM = M / BM; nN = N / BM; nwg = nM * nN; G = G_; c = c_; }
    __host__ __device__ bool next(int i, Unit& u) const {
        const long L = (long)i * G + c; if (L >= nwg) return false;
        int wgid = (int)L; { const int q = nwg / NXCD, r = nwg % NXCD, xcd = wgid % NXCD, off = wgid / NXCD; wgid = (xcd < r ? xcd * (q + 1) : r * (q + 1) + (xcd - r) * q) + off; }
        const int nig = WGM * nN, gid = wgid / nig, fm = gid * WGM, gsz = (nM - fm) < WGM ? (nM - fm) : WGM;
        u.pm = fm + ((wgid % nig) % gsz); u.pn = (wgid % nig) / gsz; return true;
    }
    __device__ __forceinline__ void a_ready(const Unit&) const {}
    __device__ __forceinline__ void done(const Unit&) const {}
};

__device__ __forceinline__ unsigned cvt_pk_bf16(float lo, float hi) { unsigned r; asm volatile("v_cvt_pk_bf16_f32 %0, %1, %2" : "=v"(r) : "v"(lo), "v"(hi)); return r; }
template <class Epi, class Sched, bool ALIGN_EPI = false, bool SP2 = false>
__device__ __forceinline__ void gemm_phase(PG8_LAS unsigned char* lds, const Gemm g, const Sched& S, const Epi& E) {
    const int tid = threadIdx.x, wid = __builtin_amdgcn_readfirstlane(tid >> 6), lane = tid & 63, wr = wid >> 2, wc = wid & 3, fr = lane & 15, fq = lane >> 4;
    const int K = g.K, nt = K / BK;
    unsigned voffA[2], voffB[2];
#pragma unroll
    for (int i = 0; i < 2; ++i) { int R, C; stage_rc(tid * 16 + i * 8192, R, C); const int Rb = 64 * (R >> 5) + perm32(R & 31);
        voffA[i] = (unsigned)(R * g.lda + C) * 2u; voffB[i] = (unsigned)(Rb * K + C) * 2u; }
    const size_t kstep = (size_t)(BK * 2);
    const size_t hstepA = (size_t)HALF * g.lda * 2, tstepA = 2 * hstepA;
    const size_t hstepB = (size_t)32 * K * 2, tstepB = (size_t)BM * K * 2;
    const unsigned ldsw = (unsigned)wid * 1024u;
    const int aoff = lds_byte(wr * 64 + fr, fq * 8), boff = lds_byte(wc * 32 + fr, fq * 8);
#define PG8_SA(b, h) (((b) * 2 + (h)) * HTB)
#define PG8_SB(b, h) ((4 + (b) * 2 + (h)) * HTB)
#define PG8_STAGE(bufoff, gbase, voff) do { _Pragma("unroll") for (int _i = 0; _i < 2; ++_i) \
        __builtin_amdgcn_global_load_lds((const unsigned*)((const char*)(gbase) + (voff)[_i]), (PG8_LAS unsigned*)(lds + (bufoff) + ldsw + _i * 8192), 16, 0, 0); } while (0)
#define PG8_LDA(dst, b, h) do { _Pragma("unroll") for (int m = 0; m < 4; ++m) _Pragma("unroll") for (int k = 0; k < 2; ++k) dst[m][k] = *(const PG8_LAS bf16x8*)(lds + PG8_SA(b, h) + aoff + m * 2048 + k * 1024); } while (0)
#define PG8_LDB(dst, b, h) do { _Pragma("unroll") for (int n = 0; n < 2; ++n) _Pragma("unroll") for (int k = 0; k < 2; ++k) dst[n][k] = *(const PG8_LAS bf16x8*)(lds + PG8_SB(b, h) + boff + n * 2048 + k * 1024); } while (0)
#define PG8_MMA(ai, bj, At, Bt) do { __builtin_amdgcn_s_setprio(1); _Pragma("unroll") for (int m = 0; m < 4; ++m) _Pragma("unroll") for (int n = 0; n < 2; ++n) _Pragma("unroll") for (int k = 0; k < 2; ++k) \
        acc[ai][bj][m][n] = __builtin_amdgcn_mfma_f32_16x16x32_bf16(Bt[n][k], At[m][k], acc[ai][bj][m][n], 0, 0, 0); __builtin_amdgcn_s_setprio(0); } while (0)
#define PG8_WAIT_V(n) asm volatile("s_waitcnt vmcnt(" #n ")" ::: "memory")
#define PG8_WAIT_L(n) asm volatile("s_waitcnt lgkmcnt(" #n ")" ::: "memory")
#define PG8_BAR __builtin_amdgcn_s_barrier()
#define PG8_SCHED __builtin_amdgcn_sched_barrier(0)
    Unit cur, nxt; int ui = 0;
    if (!S.next(0, cur)) return;
    f32x4 acc[2][2][4][2];
#pragma unroll
    for (int a = 0; a < 2; ++a)
#pragma unroll
        for (int b = 0; b < 2; ++b)
#pragma unroll
            for (int m = 0; m < 4; ++m)
#pragma unroll
                for (int n = 0; n < 2; ++n) acc[a][b][m][n] = (f32x4){0.f, 0.f, 0.f, 0.f};
    bf16x8 At[4][2], B0[2][2], B1[2][2];
    const char* cA = (const char*)g.A + (size_t)cur.pm * tstepA; const char* cB = (const char*)g.Bt + (size_t)cur.pn * tstepB;
    S.a_ready(cur);
    if constexpr (SP2) {
        PG8_STAGE(PG8_SB(0, 0), cB, voffB); PG8_STAGE(PG8_SB(0, 1), cB + hstepB, voffB); PG8_STAGE(PG8_SA(0, 0), cA, voffA); PG8_STAGE(PG8_SA(0, 1), cA + hstepA, voffA);
        if (wr == 1) PG8_BAR;
        PG8_WAIT_V(2); PG8_BAR;
        PG8_STAGE(PG8_SB(1, 0), cB + kstep, voffB); PG8_STAGE(PG8_SA(1, 0), cA + kstep, voffA); PG8_STAGE(PG8_SB(1, 1), cB + hstepB + kstep, voffB);
        PG8_WAIT_V(6); PG8_BAR;
    } else {
        PG8_STAGE(PG8_SB(0, 0), cB, voffB); PG8_STAGE(PG8_SA(0, 0), cA, voffA); PG8_STAGE(PG8_SB(0, 1), cB + hstepB, voffB); PG8_STAGE(PG8_SA(0, 1), cA + hstepA, voffA);
        if (wr == 1) PG8_BAR;
        PG8_WAIT_V(4); PG8_BAR;
        PG8_STAGE(PG8_SB(1, 0), cB + kstep, voffB); PG8_STAGE(PG8_SA(1, 0), cA + kstep, voffA); PG8_STAGE(PG8_SB(1, 1), cB + hstepB + kstep, voffB);
        PG8_WAIT_V(6); PG8_BAR;
    }
    for (;;) {
        const bool has_next = S.next(ui + 1, nxt);
        const char* nA = has_next ? (const char*)g.A + (size_t)nxt.pm * tstepA : cA; const char* nB = has_next ? (const char*)g.Bt + (size_t)nxt.pn * tstepB : cB;
        for (int t = 0; t < nt; t += 2) {
            const bool last = (t == nt - 2);
            const char* a1 = cA + (size_t)(t + 1) * kstep;
            const char* a2 = last ? nA : cA + (size_t)(t + 2) * kstep; const char* b2 = last ? nB : cB + (size_t)(t + 2) * kstep;
            const char* a3 = a2 + kstep; const char* b3 = b2 + kstep;
            if (last && has_next) S.a_ready(nxt);
            if constexpr (SP2) {
            PG8_LDB(B0, 0, 0); PG8_LDB(B1, 0, 1); PG8_SCHED; PG8_LDA(At, 0, 0); PG8_STAGE(PG8_SA(1, 1), a1 + hstepA, voffA);
            PG8_WAIT_V(8); PG8_WAIT_L(0); PG8_BAR; PG8_MMA(0, 0, At, B0); PG8_MMA(0, 1, At, B1); PG8_BAR; PG8_SCHED;
            PG8_LDA(At, 0, 1); PG8_STAGE(PG8_SB(0, 0), b2, voffB); PG8_STAGE(PG8_SB(0, 1), b2 + hstepB, voffB); PG8_STAGE(PG8_SA(0, 0), a2, voffA);
            PG8_WAIT_V(8); PG8_WAIT_L(0); PG8_BAR; PG8_MMA(1, 0, At, B0); PG8_MMA(1, 1, At, B1); PG8_BAR; PG8_SCHED;
            PG8_LDB(B0, 1, 0); PG8_LDB(B1, 1, 1); PG8_SCHED; PG8_LDA(At, 1, 0); PG8_STAGE(PG8_SA(0, 1), a2 + hstepA, voffA);
            PG8_WAIT_V(8); PG8_WAIT_L(0); PG8_BAR; PG8_MMA(0, 0, At, B0); PG8_MMA(0, 1, At, B1); PG8_BAR; PG8_SCHED;
            PG8_LDA(At, 1, 1); PG8_STAGE(PG8_SB(1, 0), b3, voffB); PG8_STAGE(PG8_SB(1, 1), b3 + hstepB, voffB); PG8_STAGE(PG8_SA(1, 0), a3, voffA);
            PG8_WAIT_V(8); PG8_WAIT_L(0); PG8_BAR; PG8_MMA(1, 0, At, B0); PG8_MMA(1, 1, At, B1); PG8_BAR; PG8_SCHED;
            } else {
            PG8_LDB(B0, 0, 0); PG8_SCHED; PG8_LDA(At, 0, 0); PG8_STAGE(PG8_SA(1, 1), a1 + hstepA, voffA);
            PG8_WAIT_L(8); PG8_BAR; PG8_WAIT_L(0); PG8_MMA(0, 0, At, B0); PG8_BAR; PG8_SCHED;
            PG8_LDB(B1, 0, 1); PG8_STAGE(PG8_SB(0, 0), b2, voffB);
            PG8_BAR; PG8_WAIT_L(0); PG8_MMA(0, 1, At, B1); PG8_BAR;
            PG8_LDA(At, 0, 1); PG8_STAGE(PG8_SA(0, 0), a2, voffA);
            PG8_BAR; PG8_WAIT_L(0); PG8_MMA(1, 0, At, B0); PG8_BAR; PG8_SCHED;
            PG8_STAGE(PG8_SB(0, 1), b2 + hstepB, voffB);
            PG8_WAIT_V(6); PG8_BAR; PG8_MMA(1, 1, At, B1); PG8_BAR;
            PG8_LDB(B0, 1, 0); PG8_SCHED; PG8_LDA(At, 1, 0); PG8_STAGE(PG8_SA(0, 1), a2 + hstepA, voffA);
            PG8_WAIT_L(8); PG8_BAR; PG8_WAIT_L(0); PG8_MMA(0, 0, At, B0); PG8_BAR; PG8_SCHED;
            PG8_LDB(B1, 1, 1); PG8_STAGE(PG8_SB(1, 0), b3, voffB);
            PG8_BAR; PG8_WAIT_L(0); PG8_MMA(0, 1, At, B1); PG8_BAR;
            PG8_LDA(At, 1, 1); PG8_STAGE(PG8_SA(1, 0), a3, voffA);
            PG8_BAR; PG8_WAIT_L(0); PG8_MMA(1, 0, At, B0); PG8_BAR; PG8_SCHED;
            PG8_STAGE(PG8_SB(1, 1), b3 + hstepB, voffB);
            PG8_WAIT_V(6); PG8_BAR; PG8_MMA(1, 1, At, B1); PG8_BAR;
            }
        }
        if constexpr (ALIGN_EPI) { if (wr == 0) PG8_BAR; }
        if constexpr (!Epi::AFTER_DRAIN) { E(acc, cur, wr, wc, fr, fq); S.done(cur); }
        if (!has_next) break;
#pragma unroll
        for (int a = 0; a < 2; ++a)
#pragma unroll
            for (int b = 0; b < 2; ++b)
#pragma unroll
                for (int m = 0; m < 4; ++m)
#pragma unroll
                    for (int n = 0; n < 2; ++n) acc[a][b][m][n] = (f32x4){0.f, 0.f, 0.f, 0.f};
        cur = nxt; cA = nA; cB = nB; ++ui;
        if constexpr (ALIGN_EPI) { if (wr == 1) PG8_BAR; }
    }
    PG8_WAIT_V(0);
    if constexpr (!ALIGN_EPI) { if (wr == 0) PG8_BAR; }
    PG8_BAR;
    if constexpr (Epi::AFTER_DRAIN) { E.fused(acc, cur, wr, wc, fr, fq, lds, wid, lane); S.done(cur); }
#undef PG8_SA
#undef PG8_SB
#undef PG8_STAGE
#undef PG8_LDA
#undef PG8_LDB
#undef PG8_MMA
#undef PG8_WAIT_V
#undef PG8_WAIT_L
#undef PG8_BAR
#undef PG8_SCHED
}
}

constexpr int NWAVES = 8;
constexpr int DM = 1024, MROWS = 32768, MP = 16384;
constexpr int NAB = 2816, NCC = 2304;
constexpr float EPS = 1e-6f, LOG2E = 1.4426950408889634f, QSCALE = 0.125f * 1.4426950408889634f;
constexpr int ZA_Q = 0, ZA_K = 512, ZA_V = 640, ZB_Q = 768, ZB_K = 1024, ZB_V = 1280, ZA_G = 1792, ZB_G = 2304;
constexpr int ZC_Q = 0, ZC_K = 1024, ZC_V = 1152, ZC_G = 1280;

constexpr size_t MiB = 1u << 20;
constexpr size_t WS_CTL = 0, CTL_ZERO_BYTES = 64 * 1024;
constexpr size_t WS_AXT = 1 * MiB;
constexpr size_t WS_LINT = 1 * MiB + 65536;
constexpr size_t WS_PART1 = 3 * MiB, WS_PART2 = 5 * MiB;
constexpr size_t WS_WOAB = 7 * MiB, WS_WC = 9 * MiB, WS_WOC = 14 * MiB;
constexpr size_t WS_Z = 16 * MiB;
constexpr size_t WS_B = 192 * MiB;
constexpr size_t WS_END = 256 * MiB;
constexpr size_t OUT_XN = 0, OUT_WAB = 64 * MiB;

constexpr int CW_BAR = 1024;

constexpr int RING_OFF = 0, RING_BYTES = 131072;
constexpr int LDSCTL_OFF = RING_BYTES, MISC_OFF = LDSCTL_OFF + 320;
constexpr int LDS_BYTES = 147456;

#define GAS __attribute__((address_space(1)))
#define LAS __attribute__((address_space(3)))
typedef unsigned short bf16;
typedef unsigned v4u __attribute__((ext_vector_type(4)));
typedef float f32x4 __attribute__((ext_vector_type(4)));
typedef float f32x2 __attribute__((ext_vector_type(2)));
#define LDS_WAIT() asm volatile("s_waitcnt lgkmcnt(0)" ::: "memory")
#define VM_WAIT() asm volatile("s_waitcnt vmcnt(0)" ::: "memory")
__device__ __forceinline__ unsigned f2bf(float f) { unsigned u = __builtin_bit_cast(unsigned, f); return (u + 0x7fffu + ((u >> 16) & 1u)) >> 16; }
__device__ __forceinline__ unsigned pk2(float lo, float hi) { return f2bf(lo) | (f2bf(hi) << 16); }
__device__ __forceinline__ float bf_lo(unsigned w) { return __builtin_bit_cast(float, w << 16); }
__device__ __forceinline__ float bf_hi(unsigned w) { return __builtin_bit_cast(float, w & 0xffff0000u); }
__device__ __forceinline__ int seq_pos(int row) { return row < MP ? (row & 4095) : (row & 2047); }
__device__ __forceinline__ float silu_f(float v) { return v * __builtin_amdgcn_rcpf(1.f + __builtin_amdgcn_exp2f(-v * LOG2E)); }

#define XB_TMO      128
#define XB_XCNT(j)  (256  + 64 * (j))
#define XB_XSUB(j)  (1280 + 64 * (j))
#define XB_XGEN(j)  (2304 + 64 * (j))
#define XB_TOP      3328
#define XB_TOPGEN   3392
#define XCD_BAR_WORDS 3456
#define XB_SPIN_CAP (1u << 18)
__device__ __forceinline__ unsigned xb_ld(unsigned* p)              { return __hip_atomic_load(p, __ATOMIC_RELAXED, __HIP_MEMORY_SCOPE_AGENT); }
__device__ __forceinline__ unsigned xb_add(unsigned* p, unsigned v) { return __hip_atomic_fetch_add(p, v, __ATOMIC_RELAXED, __HIP_MEMORY_SCOPE_AGENT); }
__device__ __forceinline__ unsigned xb_xcc_id() { return (unsigned)__builtin_amdgcn_s_getreg((3 << 11) | 20) & 0xFu; }
#define XB_SPIN(cond, bar) do { unsigned _sp = 0; while (cond) { __builtin_amdgcn_s_sleep(1); \
    if ((++_sp & 255u) == 0u) { if (xb_ld(&(bar)[XB_TMO])) break; if (_sp > XB_SPIN_CAP) { atomicAdd(&(bar)[XB_TMO], 1u); break; } } } } while (0)
struct XcdBarrier { unsigned* bar; unsigned x; volatile LAS unsigned* st; };
__device__ __forceinline__ XcdBarrier xcd_barrier_post(unsigned* bar, volatile LAS unsigned* st) {
    XcdBarrier b; b.bar = bar; b.x = xb_xcc_id(); b.st = st;
    if (threadIdx.x == 0) (void)xb_add(&bar[XB_XCNT(b.x)], 1u);
    return b;
}
__device__ __forceinline__ void xcd_barrier_complete(unsigned* bar, unsigned x, unsigned& nloc, unsigned& nx) {
    const unsigned G = gridDim.x * gridDim.y * gridDim.z;
    unsigned sum, cnt, mine, sp = 0u;
    for (;;) {
        sum = 0u; cnt = 0u; mine = 0u;
#pragma unroll
        for (unsigned j = 0; j < 16; ++j) { const unsigned c = xb_ld(&bar[XB_XCNT(j)]); sum += c; cnt += (c > 0u) ? 1u : 0u; mine = (j == x) ? c : mine; }
        if (sum == G) break;
        __builtin_amdgcn_s_sleep(1);
        if ((++sp & 255u) == 0u) { if (xb_ld(&bar[XB_TMO])) break; if (sp > XB_SPIN_CAP) { atomicAdd(&bar[XB_TMO], 1u); break; } }
    }
    nloc = mine > 0u ? mine : 1u; nx = cnt > 0u ? cnt : 1u;
}
__device__ __forceinline__ void xcd_barrier(const XcdBarrier& b) {
    asm volatile("s_waitcnt vmcnt(0)" ::: "memory");
    __syncthreads();
    if (threadIdx.x == 0) {
        unsigned* bar = b.bar;
        __builtin_amdgcn_s_waitcnt(0);
        unsigned nloc = b.st[0], nx = b.st[1];
        if (nloc == 0u) { xcd_barrier_complete(bar, b.x, nloc, nx); b.st[0] = nloc; b.st[1] = nx; }
        const unsigned old = xb_add(&bar[XB_XSUB(b.x)], 1u);
        const unsigned gen = old / nloc;
        if (old + 1u == (gen + 1u) * nloc) {
            __builtin_amdgcn_fence(__ATOMIC_RELEASE, "agent");
            asm volatile("s_waitcnt vmcnt(0)" ::: "memory");
            const unsigned og = xb_add(&bar[XB_TOP], 1u);
            const unsigned tg = og / nx;
            if (og + 1u == (tg + 1u) * nx) xb_add(&bar[XB_TOPGEN], 1u);
            else XB_SPIN(xb_ld(&bar[XB_TOPGEN]) == tg, bar);
            __builtin_amdgcn_fence(__ATOMIC_ACQUIRE, "agent");
            xb_add(&bar[XB_XGEN(b.x)], 1u);
            asm volatile("s_waitcnt vmcnt(0)" ::: "memory");
        } else {
            XB_SPIN(xb_ld(&bar[XB_XGEN(b.x)]) == gen, bar);
            __builtin_amdgcn_fence(__ATOMIC_ACQUIRE, "agent");
            asm volatile("s_waitcnt vmcnt(0)" ::: "memory");
        }
    }
    __syncthreads();
}

using pg8::Unit; using pg8::cvt_pk_bf16;
__device__ __forceinline__ f32x4 rot4(f32x4 y, f32x4 cs) { return (f32x4){y.x * cs.x - y.y * cs.y, y.x * cs.y + y.y * cs.x, y.z * cs.z - y.w * cs.w, y.z * cs.w + y.w * cs.z}; }
__device__ __forceinline__ f32x4 silu4(f32x4 v) { return (f32x4){silu_f(v.x), silu_f(v.y), silu_f(v.z), silu_f(v.w)}; }
__device__ __forceinline__ v4u pack8(f32x4 a, f32x4 b) { v4u w; w.x = cvt_pk_bf16(a.x, a.y); w.y = cvt_pk_bf16(a.z, a.w); w.z = cvt_pk_bf16(b.x, b.y); w.w = cvt_pk_bf16(b.z, b.w); return w; }

struct EpiInAB {
    static constexpr bool AFTER_DRAIN = false;
    bf16* Z; const float* gain; const float* axtab; const float* lintab;
    __device__ __forceinline__ void operator()(const f32x4 (&acc)[2][2][4][2], const Unit& u, int wr, int wc, int fr, int fq) const {
        const int pn = u.pn;
        int kind;
        if (pn < 2) kind = 1; else if (pn == 2) kind = (wc < 2) ? 2 : 0; else if (pn == 3) kind = 3; else if (pn == 4) kind = 4; else if (pn < 7) kind = 0; else kind = 5;
        const int colw = pn * 256 + wc * 64 + fq * 8;
        f32x4 gv[2][2];
        if (kind == 1 || kind == 2) {
            const float* gp = gain + (kind == 2 ? 64 : 0);
#pragma unroll
            for (int bj = 0; bj < 2; ++bj)
#pragma unroll
                for (int n = 0; n < 2; ++n) gv[bj][n] = *(const f32x4*)(gp + bj * 32 + fq * 8 + n * 4);
        }
#pragma unroll
        for (int ai = 0; ai < 2; ++ai)
#pragma unroll
            for (int m = 0; m < 4; ++m) {
                const int row = u.pm * 256 + ai * 128 + wr * 64 + m * 16 + fr; const int t = seq_pos(row);
                f32x4 v[2][2];
#pragma unroll
                for (int bj = 0; bj < 2; ++bj)
#pragma unroll
                    for (int n = 0; n < 2; ++n) v[bj][n] = acc[ai][bj][m][n];
                if (kind == 1 || kind == 2) {
                    float ss = 0.f;
#pragma unroll
                    for (int bj = 0; bj < 2; ++bj)
#pragma unroll
                        for (int n = 0; n < 2; ++n) { const f32x4 x = v[bj][n]; ss += (x.x * x.x + x.y * x.y) + (x.z * x.z + x.w * x.w); }
                    ss += __shfl_xor(ss, 16); ss += __shfl_xor(ss, 32);
                    const float rinv = rsqrtf(ss * (1.f / 64.f) + EPS) ;
                    const float sc = (kind == 1) ? QSCALE : 1.f;
#pragma unroll
                    for (int bj = 0; bj < 2; ++bj) { const int pos = bj == 0 ? (t >> 6) : (t & 63);
#pragma unroll
                        for (int n = 0; n < 2; ++n) { const f32x4 cs = *(const f32x4*)(axtab + (pos * 16 + 4 * fq + 2 * n) * 2);
                            v[bj][n] = rot4(v[bj][n] * rinv * gv[bj][n], cs) * sc; } }
                } else if (kind == 3 || kind == 4) {
                    const float sc = (kind == 4) ? 0.125f : 1.f;
#pragma unroll
                    for (int bj = 0; bj < 2; ++bj)
#pragma unroll
                        for (int n = 0; n < 2; ++n) { const f32x4 cs = *(const f32x4*)(lintab + ((size_t)t * 32 + 16 * bj + 4 * fq + 2 * n) * 2);
                            v[bj][n] = rot4(v[bj][n], cs) * sc; }
                } else if (kind == 5) {
#pragma unroll
                    for (int bj = 0; bj < 2; ++bj)
#pragma unroll
                        for (int n = 0; n < 2; ++n) v[bj][n] = silu4(v[bj][n]);
                }
                bf16* rowp = Z + (size_t)row * NAB + colw;
#pragma unroll
                for (int bj = 0; bj < 2; ++bj) *(v4u*)(rowp + bj * 32) = pack8(v[bj][0], v[bj][1]);
            }
    }
};
struct EpiOut {
    static constexpr bool AFTER_DRAIN = false;
    const float* base0; const float* base1;
    float* out; bf16* xbf; float* part;
    __device__ __forceinline__ void operator()(const f32x4 (&acc)[2][2][4][2], const Unit& u, int wr, int wc, int fr, int fq) const {
        const int colw = u.pn * 256 + wc * 64 + fq * 8;
#pragma unroll
        for (int ai = 0; ai < 2; ++ai)
#pragma unroll
            for (int m = 0; m < 4; ++m) {
                const int row = u.pm * 256 + ai * 128 + wr * 64 + m * 16 + fr;
                const float* bp = (row < MP ? base0 + (size_t)row * DM : base1 + (size_t)(row - MP) * DM) + colw;
                float* op = out + (size_t)row * DM + colw;
                float ss = 0.f; f32x4 o[2][2];
#pragma unroll
                for (int bj = 0; bj < 2; ++bj)
#pragma unroll
                    for (int n = 0; n < 2; ++n) { const f32x4 b = *(const f32x4*)(bp + bj * 32 + n * 4); const f32x4 x = b + acc[ai][bj][m][n]; o[bj][n] = x;
                        ss += (x.x * x.x + x.y * x.y) + (x.z * x.z + x.w * x.w); }
#pragma unroll
                for (int bj = 0; bj < 2; ++bj)
#pragma unroll
                    for (int n = 0; n < 2; ++n) *(f32x4*)(op + bj * 32 + n * 4) = o[bj][n];
                if (xbf) {
#pragma unroll
                    for (int bj = 0; bj < 2; ++bj) *(v4u*)(xbf + (size_t)row * DM + colw + bj * 32) = pack8(o[bj][0], o[bj][1]);
                }
                ss += __shfl_xor(ss, 16); ss += __shfl_xor(ss, 32);
                if (fq == 0) part[(size_t)row * 16 + u.pn * 4 + wc] = ss;
            }
    }
};
struct EpiInC {
    static constexpr bool AFTER_DRAIN = false;
    bf16* Z; const float* part;
    __device__ __forceinline__ void operator()(const f32x4 (&acc)[2][2][4][2], const Unit& u, int wr, int wc, int fr, int fq) const {
        const int pn = u.pn; const int kind = pn < 4 ? 1 : (pn == 4 ? 0 : 5);
        const int colw = pn * 256 + wc * 64 + fq * 8;
#pragma unroll
        for (int ai = 0; ai < 2; ++ai)
#pragma unroll
            for (int m = 0; m < 4; ++m) {
                const int row = u.pm * 256 + ai * 128 + wr * 64 + m * 16 + fr;
                const f32x4* pp = (const f32x4*)(part + (size_t)row * 16);
                const f32x4 p0 = pp[0], p1 = pp[1], p2 = pp[2], p3 = pp[3];
                const float s = ((p0.x + p0.y) + (p0.z + p0.w)) + ((p1.x + p1.y) + (p1.z + p1.w)) + ((p2.x + p2.y) + (p2.z + p2.w)) + ((p3.x + p3.y) + (p3.z + p3.w));
                float rstd = rsqrtf(s * (1.f / DM) + EPS); if (kind == 1) rstd *= QSCALE;
                bf16* rowp = Z + (size_t)row * NCC + colw;
#pragma unroll
                for (int bj = 0; bj < 2; ++bj) { f32x4 a = acc[ai][bj][m][0] * rstd, b = acc[ai][bj][m][1] * rstd;
                    if (kind == 5) { a = silu4(a); b = silu4(b); }
                    *(v4u*)(rowp + bj * 32) = pack8(a, b); }
            }
    }
};

struct Frame {
    LAS unsigned char* lds;
    volatile LAS unsigned* MISC;
    int tid, lane, wave, vcu, G;
};
__device__ __forceinline__ float wave_sum(float v) {
#pragma unroll
    for (int o = 1; o < 64; o <<= 1) v += __shfl_xor(v, o);
    return v;
}
__device__ __forceinline__ int remap_ab(int n0) { return n0 < 768 ? n0 : (n0 < 1280 ? n0 + 1024 : (n0 < 2304 ? n0 - 512 : n0)); }
__device__ __forceinline__ void p0_transpose_item(const float* W, int K, int N, const float* g, bool remap, bf16* WT, LAS float* scr, int item, int lane) {
    const int nblk = N / 32, kb = item / nblk, nb = item % nblk, k0 = 64 * kb, n0 = 32 * nb;
    const int d0 = remap ? remap_ab(n0) : n0;
#pragma unroll 8
    for (int i = 0; i < 32; ++i) { const int kk = 2 * i + (lane >> 5); const float gs = g ? g[k0 + kk] : 1.f; scr[kk * 33 + (lane & 31)] = W[(size_t)(k0 + kk) * N + n0 + (lane & 31)] * gs; }
    LDS_WAIT(); asm volatile("" ::: "memory");
    const int c = lane & 7;
#pragma unroll
    for (int j = 0; j < 4; ++j) { const int n = (lane >> 3) + 8 * j; const LAS float* s = scr + (8 * c) * 33 + n;
        v4u o; o.x = pk2(s[0 * 33], s[1 * 33]); o.y = pk2(s[2 * 33], s[3 * 33]); o.z = pk2(s[4 * 33], s[5 * 33]); o.w = pk2(s[6 * 33], s[7 * 33]);
        *(GAS v4u*)(WT + (size_t)(d0 + n) * K + k0 + 8 * c) = o; }
    LDS_WAIT(); asm volatile("" ::: "memory");
}
__device__ __forceinline__ void rms_row_to_bf16(int lane, const float* xrow, bf16* orow) {
    const GAS f32x4* xr = (const GAS f32x4*)xrow + lane;
    f32x4 v[4]; float s = 0.f;
#pragma unroll
    for (int j = 0; j < 4; ++j) { v[j] = xr[64 * j]; s += (v[j].x * v[j].x + v[j].y * v[j].y) + (v[j].z * v[j].z + v[j].w * v[j].w); }
    const float rstd = rsqrtf(wave_sum(s) * (1.f / DM) + EPS);
    GAS unsigned long long* o8 = (GAS unsigned long long*)orow + lane;
#pragma unroll
    for (int j = 0; j < 4; ++j) o8[64 * j] = (unsigned long long)pk2(v[j].x * rstd, v[j].y * rstd) | ((unsigned long long)pk2(v[j].z * rstd, v[j].w * rstd) << 32);
}

__device__ __forceinline__ int t5_bucket(int rel) {
    const int d = rel < 0 ? -rel : rel; int b;
    if (d < 8) b = d; else if (d < 12) b = 8; else if (d < 16) b = 9; else if (d < 23) b = 10; else if (d < 32) b = 11; else if (d < 46) b = 12; else if (d < 64) b = 13; else if (d < 91) b = 14; else b = 15;
    return b + (rel > 0 ? 16 : 0);
}
template <int MODE> __device__ __forceinline__ void sc_attn_item(Frame& F, bf16* Z, int item, const float* sink, const float* rel_bias) {
    constexpr int LD = MODE == 0 ? NAB : NCC;
    const int h = item >> 6, bq = item & 63, row0 = bq * 512;
    const int sbase = row0 < MP ? (row0 & ~4095) : (MP + ((row0 - MP) & ~2047)), slen = row0 < MP ? 4096 : 2048;
    const int qcol = (MODE == 0 ? ZA_Q : ZC_Q) + h * 64, kcol = MODE == 0 ? ZA_K + (h >> 2) * 64 : ZC_K + (h >> 3) * 64, vcol = MODE == 0 ? ZA_V + (h >> 2) * 64 : ZC_V + (h >> 3) * 64;
    const int gcol = (MODE == 0 ? ZA_G : ZC_G) + h * 64;
    LAS float* Kt = (LAS float*)(F.lds + RING_OFF); LAS float* Vt = Kt + 64 * 64; LAS float* tab = Vt + 64 * 64;
    const int row = row0 + F.tid, ipos = row - sbase;
    float q[64], o[64];
    { const v4u* qp = (const v4u*)(Z + (size_t)row * LD + qcol);
#pragma unroll
      for (int c = 0; c < 8; ++c) { const v4u w = qp[c]; q[8 * c + 0] = bf_lo(w.x); q[8 * c + 1] = bf_hi(w.x); q[8 * c + 2] = bf_lo(w.y); q[8 * c + 3] = bf_hi(w.y); q[8 * c + 4] = bf_lo(w.z); q[8 * c + 5] = bf_hi(w.z); q[8 * c + 6] = bf_lo(w.w); q[8 * c + 7] = bf_hi(w.w); } }
#pragma unroll
    for (int d = 0; d < 64; ++d) o[d] = 0.f;
    float mrun = -1e30f, lrun = 0.f;
    int k_lo = 0, k_hi = slen;
    if (MODE == 1) {
        __syncthreads();
        if (F.tid < 257) tab[F.tid] = rel_bias[t5_bucket(F.tid - 128) * 16 + h] * LOG2E;
        mrun = sink[h] * LOG2E; lrun = 1.f;
        const int p0 = row0 - sbase; k_lo = p0 - 128 < 0 ? 0 : p0 - 128; k_hi = p0 + 512 + 128 > slen ? slen : p0 + 512 + 128;
    }
    for (int k0 = k_lo; k0 < k_hi; k0 += 64) {
        __syncthreads();
        { const int key = F.tid >> 3, ch = F.tid & 7; const bf16* rp = Z + (size_t)(sbase + k0 + key) * LD;
          const v4u kw = *(const v4u*)(rp + kcol + ch * 8), vw = *(const v4u*)(rp + vcol + ch * 8);
          LAS float* kd = Kt + key * 64 + ch * 8; LAS float* vd = Vt + key * 64 + ch * 8;
          kd[0] = bf_lo(kw.x); kd[1] = bf_hi(kw.x); kd[2] = bf_lo(kw.y); kd[3] = bf_hi(kw.y); kd[4] = bf_lo(kw.z); kd[5] = bf_hi(kw.z); kd[6] = bf_lo(kw.w); kd[7] = bf_hi(kw.w);
          vd[0] = bf_lo(vw.x); vd[1] = bf_hi(vw.x); vd[2] = bf_lo(vw.y); vd[3] = bf_hi(vw.y); vd[4] = bf_lo(vw.z); vd[5] = bf_hi(vw.z); vd[6] = bf_lo(vw.w); vd[7] = bf_hi(vw.w); }
        __syncthreads();
        for (int j = 0; j < 64; ++j) {
            const int rel = k0 + j - ipos;
            if (MODE == 1 && (rel > 128 || rel < -128)) continue;
            const LAS f32x4* kr = (const LAS f32x4*)(Kt + j * 64);
            float s0 = 0.f, s1 = 0.f, s2 = 0.f, s3 = 0.f;
#pragma unroll
            for (int c = 0; c < 16; ++c) { const f32x4 kv = kr[c]; s0 += q[4 * c] * kv.x; s1 += q[4 * c + 1] * kv.y; s2 += q[4 * c + 2] * kv.z; s3 += q[4 * c + 3] * kv.w; }
            float s = (s0 + s1) + (s2 + s3);
            if (MODE == 1) s += tab[rel + 128];
            const float mn = fmaxf(mrun, s), al = __builtin_amdgcn_exp2f(mrun - mn), p = __builtin_amdgcn_exp2f(s - mn);
            mrun = mn; lrun = lrun * al + p;
            const LAS f32x4* vr = (const LAS f32x4*)(Vt + j * 64);
#pragma unroll
            for (int c = 0; c < 16; ++c) { const f32x4 vv = vr[c]; o[4 * c] = o[4 * c] * al + p * vv.x; o[4 * c + 1] = o[4 * c + 1] * al + p * vv.y; o[4 * c + 2] = o[4 * c + 2] * al + p * vv.z; o[4 * c + 3] = o[4 * c + 3] * al + p * vv.w; }
        }
    }
    const float il = 1.f / lrun;
    v4u* gp = (v4u*)(Z + (size_t)row * LD + gcol);
#pragma unroll
    for (int c = 0; c < 8; ++c) { const v4u g = gp[c]; v4u w;
        w.x = pk2(o[8 * c + 0] * il * bf_lo(g.x), o[8 * c + 1] * il * bf_hi(g.x)); w.y = pk2(o[8 * c + 2] * il * bf_lo(g.y), o[8 * c + 3] * il * bf_hi(g.y));
        w.z = pk2(o[8 * c + 4] * il * bf_lo(g.z), o[8 * c + 5] * il * bf_hi(g.z)); w.w = pk2(o[8 * c + 6] * il * bf_lo(g.w), o[8 * c + 7] * il * bf_hi(g.w)); gp[c] = w; }
}
__device__ __forceinline__ void sc_ret_item(Frame& F, bf16* Z, int item, const float* ret_decay) {
    const int h = item >> 7, bq = item & 127, row0 = bq * 256;
    const int sbase = row0 < MP ? (row0 & ~4095) : (MP + ((row0 - MP) & ~2047)), slen = row0 < MP ? 4096 : 2048;
    const int qcol = ZB_Q + h * 64, kcol = ZB_K + h * 64, vcol = ZB_V + h * 128, gcol = ZB_G + h * 128;
    LAS float* Kt = (LAS float*)(F.lds + RING_OFF); LAS float* Vt = Kt + 64 * 64;
    const int row = row0 + (F.tid >> 1), half = F.tid & 1, ipos = row - sbase;
    const float lgf = -__expf(ret_decay[h]) * LOG2E, lgb = -__expf(ret_decay[4 + h]) * LOG2E;
    float q[64], o[64];
    { const v4u* qp = (const v4u*)(Z + (size_t)row * NAB + qcol);
#pragma unroll
      for (int c = 0; c < 8; ++c) { const v4u w = qp[c]; q[8 * c + 0] = bf_lo(w.x); q[8 * c + 1] = bf_hi(w.x); q[8 * c + 2] = bf_lo(w.y); q[8 * c + 3] = bf_hi(w.y); q[8 * c + 4] = bf_lo(w.z); q[8 * c + 5] = bf_hi(w.z); q[8 * c + 6] = bf_lo(w.w); q[8 * c + 7] = bf_hi(w.w); } }
#pragma unroll
    for (int d = 0; d < 64; ++d) o[d] = 0.f;
    for (int k0 = 0; k0 < slen; k0 += 64) {
        __syncthreads();
        { const int key = F.tid >> 3, ch = F.tid & 7; const bf16* rp = Z + (size_t)(sbase + k0 + key) * NAB;
          const v4u kw = *(const v4u*)(rp + kcol + ch * 8), vw = *(const v4u*)(rp + vcol + ch * 8), vw2 = *(const v4u*)(rp + vcol + 64 + ch * 8);
          LAS float* kd = Kt + key * 64 + ch * 8; LAS float* vd = Vt + key * 128 + ch * 8; LAS float* vd2 = vd + 64;
          kd[0] = bf_lo(kw.x); kd[1] = bf_hi(kw.x); kd[2] = bf_lo(kw.y); kd[3] = bf_hi(kw.y); kd[4] = bf_lo(kw.z); kd[5] = bf_hi(kw.z); kd[6] = bf_lo(kw.w); kd[7] = bf_hi(kw.w);
          vd[0] = bf_lo(vw.x); vd[1] = bf_hi(vw.x); vd[2] = bf_lo(vw.y); vd[3] = bf_hi(vw.y); vd[4] = bf_lo(vw.z); vd[5] = bf_hi(vw.z); vd[6] = bf_lo(vw.w); vd[7] = bf_hi(vw.w);
          vd2[0] = bf_lo(vw2.x); vd2[1] = bf_hi(vw2.x); vd2[2] = bf_lo(vw2.y); vd2[3] = bf_hi(vw2.y); vd2[4] = bf_lo(vw2.z); vd2[5] = bf_hi(vw2.z); vd2[6] = bf_lo(vw2.w); vd2[7] = bf_hi(vw2.w); }
        __syncthreads();
        for (int j = 0; j < 64; ++j) {
            const int d = ipos - (k0 + j);
            const float w = d >= 0 ? __builtin_amdgcn_exp2f(lgf * (float)d) : __builtin_amdgcn_exp2f(lgb * (float)(-d));
            const LAS f32x4* kr = (const LAS f32x4*)(Kt + j * 64);
            float s0 = 0.f, s1 = 0.f, s2 = 0.f, s3 = 0.f;
#pragma unroll
            for (int c = 0; c < 16; ++c) { const f32x4 kv = kr[c]; s0 += q[4 * c] * kv.x; s1 += q[4 * c + 1] * kv.y; s2 += q[4 * c + 2] * kv.z; s3 += q[4 * c + 3] * kv.w; }
            const float s = ((s0 + s1) + (s2 + s3)) * w;
            const LAS f32x4* vr = (const LAS f32x4*)(Vt + j * 128 + half * 64);
#pragma unroll
            for (int c = 0; c < 16; ++c) { const f32x4 vv = vr[c]; o[4 * c] += s * vv.x; o[4 * c + 1] += s * vv.y; o[4 * c + 2] += s * vv.z; o[4 * c + 3] += s * vv.w; }
        }
    }
    float ss = 0.f;
#pragma unroll
    for (int d = 0; d < 64; ++d) ss += o[d] * o[d];
    ss += __shfl_xor(ss, 1);
    const float r = rsqrtf(ss * (1.f / 128.f) + EPS);
    v4u* gp = (v4u*)(Z + (size_t)row * NAB + gcol + half * 64);
#pragma unroll
    for (int c = 0; c < 8; ++c) { const v4u g = gp[c]; v4u w;
        w.x = pk2(o[8 * c + 0] * r * bf_lo(g.x), o[8 * c + 1] * r * bf_hi(g.x)); w.y = pk2(o[8 * c + 2] * r * bf_lo(g.y), o[8 * c + 3] * r * bf_hi(g.y));
        w.z = pk2(o[8 * c + 4] * r * bf_lo(g.z), o[8 * c + 5] * r * bf_hi(g.z)); w.w = pk2(o[8 * c + 6] * r * bf_lo(g.w), o[8 * c + 7] * r * bf_hi(g.w)); gp[c] = w; }
}

#ifndef MK_N_LAUNCHES
#define MK_N_LAUNCHES 1
#endif
constexpr int N_PHASES = 9;
struct Args { const float* in[12]; float* out; unsigned char* ws; int ph_lo, ph_hi; };
__global__ void __launch_bounds__(NWAVES * 64, 2) mk_fwd(Args args) {
    extern __shared__ __attribute__((aligned(16))) unsigned char lds[];
    Frame F;
    F.lds = (LAS unsigned char*)lds;
    F.MISC = (volatile LAS unsigned*)(F.lds + MISC_OFF);
    F.tid = threadIdx.x; F.lane = F.tid & 63; F.wave = __builtin_amdgcn_readfirstlane(F.tid >> 6);
    F.G = gridDim.x; { const int bx = blockIdx.x; F.vcu = (F.G % 8 == 0) ? (bx % 8) * (F.G / 8) + bx / 8 : bx; }
    unsigned char* ws = args.ws;
    unsigned* ctl = (unsigned*)(ws + WS_CTL);
    const float* x_prompt = args.in[0]; const float* x_sample = args.in[1]; const float* norm_g = args.in[2]; const float* w_in_ab = args.in[3];
    const float* qk_norm = args.in[4]; const float* ret_decay = args.in[5]; const float* w_out_ab = args.in[6]; const float* w_in_c = args.in[7];
    const float* sink_c = args.in[8]; const float* w_out_c = args.in[9]; const float* rel_bias = args.in[10]; const float* final_norm = args.in[11];
    float* out = args.out;
    bf16* XN0 = (bf16*)((unsigned char*)out + OUT_XN); bf16* WAB = (bf16*)((unsigned char*)out + OUT_WAB);
    bf16* WOAB = (bf16*)(ws + WS_WOAB); bf16* WC = (bf16*)(ws + WS_WC); bf16* WOC = (bf16*)(ws + WS_WOC);
    bf16* Z = (bf16*)(ws + WS_Z); bf16* X1B = (bf16*)(ws + WS_B);
    float* AXT = (float*)(ws + WS_AXT); float* LINT = (float*)(ws + WS_LINT); float* PART1 = (float*)(ws + WS_PART1); float* PART2 = (float*)(ws + WS_PART2);

    for (int u = F.tid; u < (LDS_BYTES - LDSCTL_OFF) / 4; u += NWAVES * 64) ((LAS unsigned*)(F.lds + LDSCTL_OFF))[u] = 0u;
    __syncthreads();
    const int lo = args.ph_lo, hi = args.ph_hi;
    XcdBarrier bar; bar.bar = ctl + CW_BAR; bar.x = 0; bar.st = nullptr;
    if (hi - lo > 1) bar = xcd_barrier_post(ctl + CW_BAR, F.MISC + 8);
#define IN(k) (lo <= (k) && (k) < hi)
#define SEAM(k) do { if (IN(k) && IN((k) + 1)) xcd_barrier(bar); } while (0)

    if (IN(0)) {
        LAS float* scr = (LAS float*)(F.lds + RING_OFF + F.wave * 16384);
        const int gw = F.vcu * NWAVES + F.wave, NGW = F.G * NWAVES;
        constexpr int I_AB = 16 * (NAB / 32), I_O = 16 * 32, I_C = 16 * (NCC / 32);
        constexpr int NITEMS = I_AB + I_O + I_C + I_O;
        for (int it = gw; it < NITEMS; it += NGW) {
            int r = it;
            if (r < I_AB) { p0_transpose_item(w_in_ab, DM, NAB, norm_g, true, WAB, scr, r, F.lane); continue; } r -= I_AB;
            if (r < I_O) { p0_transpose_item(w_out_ab, DM, DM, nullptr, false, WOAB, scr, r, F.lane); continue; } r -= I_O;
            if (r < I_C) { p0_transpose_item(w_in_c, DM, NCC, norm_g + DM, false, WC, scr, r, F.lane); continue; } r -= I_C;
            p0_transpose_item(w_out_c, DM, DM, nullptr, false, WOC, scr, r, F.lane);
        }
        for (int m = gw; m < MROWS; m += NGW) rms_row_to_bf16(F.lane, m < MP ? x_prompt + (size_t)m * DM : x_sample + (size_t)(m - MP) * DM, XN0 + (size_t)m * DM);
        const int gt = blockIdx.x * (NWAVES * 64) + F.tid, NGT = F.G * NWAVES * 64;
        for (int e = gt; e < 64 * 16 + 4096 * 32; e += NGT) {
            double ang; float* dst;
            if (e < 1024) { const int pos = e >> 4, j = e & 15; ang = (double)pos * pow(10000.0, -(double)j / 16.0); dst = AXT + 2 * e; }
            else { const int e2 = e - 1024, t = e2 >> 5, j = e2 & 31; ang = (double)t * pow(10000.0, -(double)j / 32.0); dst = LINT + 2 * e2; }
            dst[0] = (float)cos(ang); dst[1] = (float)sin(ang);
        }
    }
    SEAM(0);
    if (IN(1)) {
        pg8::Gemm g{XN0, WAB, MROWS, NAB, DM, DM}; pg8::StaticOrder S; S.init(MROWS, NAB, F.G, (int)blockIdx.x);
        EpiInAB E{Z, qk_norm, AXT, LINT};
        pg8::gemm_phase<EpiInAB, pg8::StaticOrder, true, true>(F.lds + RING_OFF, g, S, E);
    }
    SEAM(1);
    if (IN(2)) {
        for (int it = blockIdx.x; it < 512 + 512; it += F.G) {
            if (it < 512) sc_attn_item<0>(F, Z, it, nullptr, nullptr); else sc_ret_item(F, Z, it - 512, ret_decay);
        }
        __syncthreads();
    }
    SEAM(3);
    if (IN(4)) {
        pg8::Gemm g{Z + ZA_G, WOAB, MROWS, DM, DM, NAB}; pg8::StaticOrder S; S.init(MROWS, DM, F.G, (int)blockIdx.x);
        EpiOut E{x_prompt, x_sample, out, X1B, PART1};
        pg8::gemm_phase<EpiOut, pg8::StaticOrder, true, true>(F.lds + RING_OFF, g, S, E);
    }
    SEAM(4);
    if (IN(5)) {
        pg8::Gemm g{X1B, WC, MROWS, NCC, DM, DM}; pg8::StaticOrder S; S.init(MROWS, NCC, F.G, (int)blockIdx.x);
        EpiInC E{Z, PART1};
        pg8::gemm_phase<EpiInC, pg8::StaticOrder, true, true>(F.lds + RING_OFF, g, S, E);
    }
    SEAM(5);
    if (IN(6)) {
        for (int it = blockIdx.x; it < 1024; it += F.G) sc_attn_item<1>(F, Z, it, sink_c, rel_bias);
        __syncthreads();
    }
    SEAM(6);
    if (IN(7)) {
        pg8::Gemm g{Z + ZC_G, WOC, MROWS, DM, DM, NCC}; pg8::StaticOrder S; S.init(MROWS, DM, F.G, (int)blockIdx.x);
        EpiOut E{out, out + (size_t)MP * DM, out, nullptr, PART2};
        pg8::gemm_phase<EpiOut, pg8::StaticOrder, true, true>(F.lds + RING_OFF, g, S, E);
    }
    SEAM(7);
    if (IN(8)) {
        const int gw = F.vcu * NWAVES + F.wave, NGW = F.G * NWAVES;
        for (int m = gw; m < MROWS; m += NGW) {
            const f32x4* pp = (const f32x4*)(PART2 + (size_t)m * 16);
            const f32x4 p0 = pp[0], p1 = pp[1], p2 = pp[2], p3 = pp[3];
            const float s = ((p0.x + p0.y) + (p0.z + p0.w)) + ((p1.x + p1.y) + (p1.z + p1.w)) + ((p2.x + p2.y) + (p2.z + p2.w)) + ((p3.x + p3.y) + (p3.z + p3.w));
            const float rstd = rsqrtf(s * (1.f / DM) + EPS);
            f32x4* xr = (f32x4*)(out + (size_t)m * DM) + F.lane; const f32x4* gr = (const f32x4*)final_norm + F.lane;
#pragma unroll
            for (int j = 0; j < 4; ++j) xr[64 * j] = xr[64 * j] * rstd * gr[64 * j];
        }
    }
#undef IN
#undef SEAM
}

extern "C" void kernel_launch(void* const* d_in, const int* in_sizes, int n_in, void* d_out, int out_size, void* d_ws, size_t ws_size, hipStream_t stream) {
    static int grid = 0;
    if (grid == 0) {
        if (n_in != 12 || out_size != MROWS * DM || ws_size < WS_END) { fprintf(stderr, "kernel_launch: unexpected shapes (n_in %d, out %d, ws %zu)\n", n_in, out_size, ws_size); grid = -1; return; }
        int dev = 0, cus = 0, per_cu = 0;
        if (hipGetDevice(&dev) != hipSuccess || hipDeviceGetAttribute(&cus, hipDeviceAttributeMultiprocessorCount, dev) != hipSuccess) { grid = -1; return; }
        if (hipFuncSetAttribute((const void*)mk_fwd, hipFuncAttributeMaxDynamicSharedMemorySize, LDS_BYTES) != hipSuccess) { fprintf(stderr, "kernel_launch: hipFuncSetAttribute failed\n"); grid = -1; return; }
        if (hipOccupancyMaxActiveBlocksPerMultiprocessor(&per_cu, (const void*)mk_fwd, NWAVES * 64, LDS_BYTES) != hipSuccess || per_cu < 1) { fprintf(stderr, "kernel_launch: occupancy query says %d blocks per CU\n", per_cu); grid = -1; (void)hipGetLastError(); return; }
        grid = cus;
    }
    if (grid < 0) return;
    (void)hipMemsetAsync((char*)d_ws + WS_CTL, 0, CTL_ZERO_BYTES, stream);
    Args a{};
    for (int i = 0; i < 12; ++i) a.in[i] = (const float*)d_in[i];
    a.out = (float*)d_out; a.ws = (unsigned char*)d_ws;
#if MK_N_LAUNCHES == 1
    a.ph_lo = 0; a.ph_hi = N_PHASES;
    void* kargs[] = {&a};
    hipError_t e = hipLaunchCooperativeKernel((const void*)mk_fwd, dim3(grid), dim3(NWAVES * 64), kargs, LDS_BYTES, stream);
    if (e != hipSuccess) fprintf(stderr, "kernel_launch: cooperative launch failed: %s\n", hipGetErrorString(e));
#else
    for (int p = 0; p < N_PHASES; ++p) { if (p == 3) continue; a.ph_lo = p; a.ph_hi = p + 1; hipLaunchKernelGGL(mk_fwd, dim3(grid), dim3(NWAVES * 64), LDS_BYTES, stream, a); }
#endif
}
```

```cpp
#include <hip/hip_runtime.h>
#include <hip/hip_bf16.h>
#include <cstdio>
#include <cstdint>
#include <cmath>
namespace pg8 {
#define PG8_LAS __attribute__((address_space(3)))
typedef unsigned short bf16_t;
typedef short bf16x8 __attribute__((ext_vector_type(8)));
typedef float f32x4 __attribute__((ext_vector_type(4)));
typedef unsigned u32x4 __attribute__((ext_vector_type(4)));
constexpr int BM = 256, BK = 64, HALF = 128, HTB = HALF * BK * 2  , STAGE_BYTES = 8 * HTB, NXCD = 8, WGM = 8;

__host__ __device__ __forceinline__ int lds_byte(int r, int c) { const int st = (r >> 4) * 2 + (c >> 5), rr = r & 15, cc = c & 31, ob = rr * 64 + cc * 2; return st * 1024 + (ob ^ (((ob >> 9) & 1) << 5)); }
__host__ __device__ __forceinline__ void stage_rc(int b, int& R, int& C) { const int st = b / 1024, sb = b % 1024, swz = sb ^ (((sb >> 9) & 1) << 5); R = (st >> 1) * 16 + swz / 64; C = (st & 1) * 32 + (swz % 64) / 2; }
__host__ __device__ __forceinline__ int perm32(int rho) { const int n = rho >> 4, i = rho & 15; return 8 * (i >> 2) + 4 * n + (i & 3); }

struct Unit { int pm, pn; };
struct Gemm { const bf16_t* A; const bf16_t* Bt; int M, N, K, lda; };

struct StaticOrder {
    int nM, nN, nwg, G, c;
    __host__ __device__ void init(int M, int N, int G_, int c_) { nM = M / BM; nN = N / BM; nwg = nM * nN; G = G_; c = c_; }
    __host__ __device__ bool next(int i, Unit& u) const {
        const long L = (long)i * G + c; if (L >= nwg) return false;
        int wgid = (int)L; { const int q = nwg / NXCD, r = nwg % NXCD, xcd = wgid % NXCD, off = wgid / NXCD; wgid = (xcd < r ? xcd * (q + 1) : r * (q + 1) + (xcd - r) * q) + off; }
        const int nig = WGM * nN, gid = wgid / nig, fm = gid * WGM, gsz = (nM - fm) < WGM ? (nM - fm) : WGM;
        u.pm = fm + ((wgid % nig) % gsz); u.pn = (wgid % nig) / gsz; return true;
    }
    __device__ __forceinline__ void a_ready(const Unit&) const {}
    __device__ __forceinline__ void done(const Unit&) const {}
};

__device__ __forceinline__ unsigned cvt_pk_bf16(float lo, float hi) { unsigned r; asm volatile("v_cvt_pk_bf16_f32 %0, %1, %2" : "=v"(r) : "v"(lo), "v"(hi)); return r; }
template <class Epi, class Sched, bool ALIGN_EPI = false, bool SP2 = false>
__device__ __forceinline__ void gemm_phase(PG8_LAS unsigned char* lds, const Gemm g, const Sched& S, const Epi& E) {
    const int tid = threadIdx.x, wid = __builtin_amdgcn_readfirstlane(tid >> 6), lane = tid & 63, wr = wid >> 2, wc = wid & 3, fr = lane & 15, fq = lane >> 4;
    const int K = g.K, nt = K / BK;
    unsigned voffA[2], voffB[2];
#pragma unroll
    for (int i = 0; i < 2; ++i) { int R, C; stage_rc(tid * 16 + i * 8192, R, C); const int Rb = 64 * (R >> 5) + perm32(R & 31);
        voffA[i] = (unsigned)(R * g.lda + C) * 2u; voffB[i] = (unsigned)(Rb * K + C) * 2u; }
    const size_t kstep = (size_t)(BK * 2);
    const size_t hstepA = (size_t)HALF * g.lda * 2, tstepA = 2 * hstepA;
    const size_t hstepB = (size_t)32 * K * 2, tstepB = (size_t)BM * K * 2;
    const unsigned ldsw = (unsigned)wid * 1024u;
    const int aoff = lds_byte(wr * 64 + fr, fq * 8), boff = lds_byte(wc * 32 + fr, fq * 8);
#define PG8_SA(b, h) (((b) * 2 + (h)) * HTB)
#define PG8_SB(b, h) ((4 + (b) * 2 + (h)) * HTB)
#define PG8_STAGE(bufoff, gbase, voff) do { _Pragma("unroll") for (int _i = 0; _i < 2; ++_i) \
        __builtin_amdgcn_global_load_lds((const unsigned*)((const char*)(gbase) + (voff)[_i]), (PG8_LAS unsigned*)(lds + (bufoff) + ldsw + _i * 8192), 16, 0, 0); } while (0)
#define PG8_LDA(dst, b, h) do { _Pragma("unroll") for (int m = 0; m < 4; ++m) _Pragma("unroll") for (int k = 0; k < 2; ++k) dst[m][k] = *(const PG8_LAS bf16x8*)(lds + PG8_SA(b, h) + aoff + m * 2048 + k * 1024); } while (0)
#define PG8_LDB(dst, b, h) do { _Pragma("unroll") for (int n = 0; n < 2; ++n) _Pragma("unroll") for (int k = 0; k < 2; ++k) dst[n][k] = *(const PG8_LAS bf16x8*)(lds + PG8_SB(b, h) + boff + n * 2048 + k * 1024); } while (0)
#define PG8_MMA(ai, bj, At, Bt) do { __builtin_amdgcn_s_setprio(1); _Pragma("unroll") for (int m = 0; m < 4; ++m) _Pragma("unroll") for (int n = 0; n < 2; ++n) _Pragma("unroll") for (int k = 0; k < 2; ++k) \
        acc[ai][bj][m][n] = __builtin_amdgcn_mfma_f32_16x16x32_bf16(Bt[n][k], At[m][k], acc[ai][bj][m][n], 0, 0, 0); __builtin_amdgcn_s_setprio(0); } while (0)
#define PG8_WAIT_V(n) asm volatile("s_waitcnt vmcnt(" #n ")" ::: "memory")
#define PG8_WAIT_L(n) asm volatile("s_waitcnt lgkmcnt(" #n ")" ::: "memory")
#define PG8_BAR __builtin_amdgcn_s_barrier()
#define PG8_SCHED __builtin_amdgcn_sched_barrier(0)
    Unit cur, nxt; int ui = 0;
    if (!S.next(0, cur)) return;
    f32x4 acc[2][2][4][2];
#pragma unroll
    for (int a = 0; a < 2; ++a)
#pragma unroll
        for (int b = 0; b < 2; ++b)
#pragma unroll
            for (int m = 0; m < 4; ++m)
#pragma unroll
                for (int n = 0; n < 2; ++n) acc[a][b][m][n] = (f32x4){0.f, 0.f, 0.f, 0.f};
    bf16x8 At[4][2], B0[2][2], B1[2][2];
    const char* cA = (const char*)g.A + (size_t)cur.pm * tstepA; const char* cB = (const char*)g.Bt + (size_t)cur.pn * tstepB;
    S.a_ready(cur);
    if constexpr (SP2) {
        PG8_STAGE(PG8_SB(0, 0), cB, voffB); PG8_STAGE(PG8_SB(0, 1), cB + hstepB, voffB); PG8_STAGE(PG8_SA(0, 0), cA, voffA); PG8_STAGE(PG8_SA(0, 1), cA + hstepA, voffA);
        if (wr == 1) PG8_BAR;
        PG8_WAIT_V(2); PG8_BAR;
        PG8_STAGE(PG8_SB(1, 0), cB + kstep, voffB); PG8_STAGE(PG8_SA(1, 0), cA + kstep, voffA); PG8_STAGE(PG8_SB(1, 1), cB + hstepB + kstep, voffB);
        PG8_WAIT_V(6); PG8_BAR;
    } else {
        PG8_STAGE(PG8_SB(0, 0), cB, voffB); PG8_STAGE(PG8_SA(0, 0), cA, voffA); PG8_STAGE(PG8_SB(0, 1), cB + hstepB, voffB); PG8_STAGE(PG8_SA(0, 1), cA + hstepA, voffA);
        if (wr == 1) PG8_BAR;
        PG8_WAIT_V(4); PG8_BAR;
        PG8_STAGE(PG8_SB(1, 0), cB + kstep, voffB); PG8_STAGE(PG8_SA(1, 0), cA + kstep, voffA); PG8_STAGE(PG8_SB(1, 1), cB + hstepB + kstep, voffB);
        PG8_WAIT_V(6); PG8_BAR;
    }
    for (;;) {
        const bool has_next = S.next(ui + 1, nxt);
        const char* nA = has_next ? (const char*)g.A + (size_t)nxt.pm * tstepA : cA; const char* nB = has_next ? (const char*)g.Bt + (size_t)nxt.pn * tstepB : cB;
        for (int t = 0; t < nt; t += 2) {
            const bool last = (t == nt - 2);
            const char* a1 = cA + (size_t)(t + 1) * kstep;
            const char* a2 = last ? nA : cA + (size_t)(t + 2) * kstep; const char* b2 = last ? nB : cB + (size_t)(t + 2) * kstep;
            const char* a3 = a2 + kstep; const char* b3 = b2 + kstep;
            if (last && has_next) S.a_ready(nxt);
            if constexpr (SP2) {
            PG8_LDB(B0, 0, 0); PG8_LDB(B1, 0, 1); PG8_SCHED; PG8_LDA(At, 0, 0); PG8_STAGE(PG8_SA(1, 1), a1 + hstepA, voffA);
            PG8_WAIT_V(8); PG8_WAIT_L(0); PG8_BAR; PG8_MMA(0, 0, At, B0); PG8_MMA(0, 1, At, B1); PG8_BAR; PG8_SCHED;
            PG8_LDA(At, 0, 1); PG8_STAGE(PG8_SB(0, 0), b2, voffB); PG8_STAGE(PG8_SB(0, 1), b2 + hstepB, voffB); PG8_STAGE(PG8_SA(0, 0), a2, voffA);
            PG8_WAIT_V(8); PG8_WAIT_L(0); PG8_BAR; PG8_MMA(1, 0, At, B0); PG8_MMA(1, 1, At, B1); PG8_BAR; PG8_SCHED;
            PG8_LDB(B0, 1, 0); PG8_LDB(B1, 1, 1); PG8_SCHED; PG8_LDA(At, 1, 0); PG8_STAGE(PG8_SA(0, 1), a2 + hstepA, voffA);
            PG8_WAIT_V(8); PG8_WAIT_L(0); PG8_BAR; PG8_MMA(0, 0, At, B0); PG8_MMA(0, 1, At, B1); PG8_BAR; PG8_SCHED;
            PG8_LDA(At, 1, 1); PG8_STAGE(PG8_SB(1, 0), b3, voffB); PG8_STAGE(PG8_SB(1, 1), b3 + hstepB, voffB); PG8_STAGE(PG8_SA(1, 0), a3, voffA);
            PG8_WAIT_V(8); PG8_WAIT_L(0); PG8_BAR; PG8_MMA(1, 0, At, B0); PG8_MMA(1, 1, At, B1); PG8_BAR; PG8_SCHED;
            } else {
            PG8_LDB(B0, 0, 0); PG8_SCHED; PG8_LDA(At, 0, 0); PG8_STAGE(PG8_SA(1, 1), a1 + hstepA, voffA);
            PG8_WAIT_L(8); PG8_BAR; PG8_WAIT_L(0); PG8_MMA(0, 0, At, B0); PG8_BAR; PG8_SCHED;
            PG8_LDB(B1, 0, 1); PG8_STAGE(PG8_SB(0, 0), b2, voffB);
            PG8_BAR; PG8_WAIT_L(0); PG8_MMA(0, 1, At, B1); PG8_BAR;
            PG8_LDA(At, 0, 1); PG8_STAGE(PG8_SA(0, 0), a2, voffA);
            PG8_BAR; PG8_WAIT_L(0); PG8_MMA(1, 0, At, B0); PG8_BAR; PG8_SCHED;
            PG8_STAGE(PG8_SB(0, 1), b2 + hstepB, voffB);
            PG8_WAIT_V(6); PG8_BAR; PG8_MMA(1, 1, At, B1); PG8_BAR;
            PG8_LDB(B0, 1, 0); PG8_SCHED; PG8_LDA(At, 1, 0); PG8_STAGE(PG8_SA(0, 1), a2 + hstepA, voffA);
            PG8_WAIT_L(8); PG8_BAR; PG8_WAIT_L(0); PG8_MMA(0, 0, At, B0); PG8_BAR; PG8_SCHED;
            PG8_LDB(B1, 1, 1); PG8_STAGE(PG8_SB(1, 0), b3, voffB);
            PG8_BAR; PG8_WAIT_L(0); PG8_MMA(0, 1, At, B1); PG8_BAR;
            PG8_LDA(At, 1, 1); PG8_STAGE(PG8_SA(1, 0), a3, voffA);
            PG8_BAR; PG8_WAIT_L(0); PG8_MMA(1, 0, At, B0); PG8_BAR; PG8_SCHED;
            PG8_STAGE(PG8_SB(1, 1), b3 + hstepB, voffB);
            PG8_WAIT_V(6); PG8_BAR; PG8_MMA(1, 1, At, B1); PG8_BAR;
            }
        }
        if constexpr (ALIGN_EPI) { if (wr == 0) PG8_BAR; }
        if constexpr (!Epi::AFTER_DRAIN) { E(acc, cur, wr, wc, fr, fq); S.done(cur); }
        if (!has_next) break;
#pragma unroll
        for (int a = 0; a < 2; ++a)
#pragma unroll
            for (int b = 0; b < 2; ++b)
#pragma unroll
                for (int m = 0; m < 4; ++m)
#pragma unroll
                    for (int n = 0; n < 2; ++n) acc[a][b][m][n] = (f32x4){0.f, 0.f, 0.f, 0.f};
        cur = nxt; cA = nA; cB = nB; ++ui;
        if constexpr (ALIGN_EPI) { if (wr == 1) PG8_BAR; }
    }
    PG8_WAIT_V(0);
    if constexpr (!ALIGN_EPI) { if (wr == 0) PG8_BAR; }
    PG8_BAR;
    if constexpr (Epi::AFTER_DRAIN) { E.fused(acc, cur, wr, wc, fr, fq, lds, wid, lane); S.done(cur); }
#undef PG8_SA
#undef PG8_SB
#undef PG8_STAGE
#undef PG8_LDA
#undef PG8_LDB
#undef PG8_MMA
#undef PG8_WAIT_V
#undef PG8_WAIT_L
#undef PG8_BAR
#undef PG8_SCHED
}
}
namespace attn_body {
using bf16=__hip_bfloat16;
using bf16x8=__attribute__((ext_vector_type(8)))short;
using s16x4=__attribute__((ext_vector_type(4)))short;
using f32x16=__attribute__((ext_vector_type(16)))float;
using u32x4=__attribute__((ext_vector_type(4)))unsigned;
constexpr int D=64;
constexpr int NW=8,QBLK=32,QB=QBLK*NW,KVBLK=64;
constexpr int ATTN_UNIT_ROWS=QB;
__device__ __forceinline__ int crow(int r,int hi){return (r&3)+8*(r>>2)+4*hi;}
#define SBAR() __builtin_amdgcn_sched_barrier(0)
constexpr int NSLOT=3, SLOTB=8192;
constexpr int LDS_K=0, LDS_V=NSLOT*SLOTB, LDS_WS=2*NSLOT*SLOTB, LDS_OST=LDS_WS+NW*64*4, LDS_TAB=LDS_OST+NW*4096, LDS_BYTES=LDS_TAB+3072;
constexpr float C2=0.125f*1.4426950408889634f;
__device__ __forceinline__ void glds16(const void*gsrc,unsigned lds_dst){unsigned keep;
  asm volatile("s_mov_b32 %0, m0\n\ts_mov_b32 m0, %2\n\ts_nop 0\n\tglobal_load_lds_dwordx4 %1, off\n\ts_mov_b32 m0, %0":"=&s"(keep):"v"(gsrc),"s"(lds_dst):"memory");}
__device__ __forceinline__ float max3f(float a,float b,float c){float r;asm("v_max3_f32 %0, %1, %2, %3":"=v"(r):"v"(a),"v"(b),"v"(c));return r;}
__device__ __forceinline__ float max2f(float a,float b){float r;asm("v_max_f32_e32 %0, %1, %2":"=v"(r):"v"(a),"v"(b));return r;}
__device__ __forceinline__ float fadd_s(float a,float b){float r;asm("v_add_f32_e32 %0, %1, %2":"=v"(r):"v"(a),"v"(b));return r;}
__device__ __forceinline__ float fsub_s(float a,float b){float r;asm("v_sub_f32_e32 %0, %1, %2":"=v"(r):"v"(a),"v"(b));return r;}
typedef float f32x2_t __attribute__((ext_vector_type(2))); typedef __bf16 bf16x2_t __attribute__((ext_vector_type(2)));
__device__ __forceinline__ unsigned cvtpk_s(float lo,float hi){f32x2_t v={lo,hi};bf16x2_t b=__builtin_convertvector(v,bf16x2_t);return __builtin_bit_cast(unsigned,b);}
#define WAIT_BAR(N) asm volatile("s_waitcnt vmcnt(" #N ") lgkmcnt(0)\n\ts_barrier":::"memory")

__device__ __forceinline__ void qkt(f32x16&p0,f32x16&p1,const char*Kslot,const bf16x8*qr,const f32x16&negm,int r32,int hi){
  const char*kb=Kslot+hi*1024+r32*16;
  #pragma unroll
  for(int d0=0;d0<4;++d0){
    const bf16x8 b0=*reinterpret_cast<const bf16x8*>(kb+d0*2048);
    const bf16x8 b1=*reinterpret_cast<const bf16x8*>(kb+d0*2048+512);
    if(d0==0){p0=__builtin_amdgcn_mfma_f32_32x32x16_bf16(b0,qr[0],negm,0,0,0);p1=__builtin_amdgcn_mfma_f32_32x32x16_bf16(b1,qr[0],negm,0,0,0);}
    else{p0=__builtin_amdgcn_mfma_f32_32x32x16_bf16(b0,qr[d0],p0,0,0,0);p1=__builtin_amdgcn_mfma_f32_32x32x16_bf16(b1,qr[d0],p1,0,0,0);}}
}
typedef __attribute__((address_space(3))) const char* lds_cptr;
typedef short v4i16_t __attribute__((ext_vector_type(4)));
__device__ __forceinline__ void kload8(bf16x8*kf,lds_cptr kp){
  kf[0]=*(const __attribute__((address_space(3))) bf16x8*)(kp);      kf[1]=*(const __attribute__((address_space(3))) bf16x8*)(kp+512);
  kf[2]=*(const __attribute__((address_space(3))) bf16x8*)(kp+2048); kf[3]=*(const __attribute__((address_space(3))) bf16x8*)(kp+2560);
  kf[4]=*(const __attribute__((address_space(3))) bf16x8*)(kp+4096); kf[5]=*(const __attribute__((address_space(3))) bf16x8*)(kp+4608);
  kf[6]=*(const __attribute__((address_space(3))) bf16x8*)(kp+6144); kf[7]=*(const __attribute__((address_space(3))) bf16x8*)(kp+6656);
}
__device__ __forceinline__ void kload2(bf16x8*kf,lds_cptr kp,int j){ kf[2*j]=*(const __attribute__((address_space(3))) bf16x8*)(kp+j*2048); kf[2*j+1]=*(const __attribute__((address_space(3))) bf16x8*)(kp+j*2048+512); }
__device__ __forceinline__ s16x4 vtr(lds_cptr p){ return __builtin_bit_cast(s16x4,__builtin_amdgcn_ds_read_tr16_b64_v4i16((__attribute__((address_space(3))) v4i16_t*)p)); }
__device__ __forceinline__ float rowmax(const f32x16&p0,const f32x16&p1){
  float a=max3f(p0[0],p0[1],p1[0]),b=max3f(p0[2],p0[3],p1[1]);a=max3f(a,p1[2],p1[3]);
  #pragma unroll
  for(int r=4;r<16;r+=4){a=max3f(a,p0[r],p0[r+1]);b=max3f(b,p0[r+2],p0[r+3]);a=max3f(a,p1[r],p1[r+1]);b=max3f(b,p1[r+2],p1[r+3]);}
  const float m=max2f(a,b);
  auto rr=__builtin_amdgcn_permlane32_swap(__float_as_uint(m),__float_as_uint(m),false,false);
  return max2f(__uint_as_float(rr[0]),__uint_as_float(rr[1]));
}
__device__ __forceinline__ void pv(f32x16*o,int vb,bf16x8 pa0,bf16x8 pa1,bf16x8 pa2,bf16x8 pa3){
  #pragma unroll
  for(int d0=0;d0<2;++d0){s16x4 lo[4],hi[4];
    #pragma unroll
    for(int ks=0;ks<4;++ks){
      asm volatile("ds_read_b64_tr_b16 %0,%1 offset:%c2":"=&v"(lo[ks]):"v"(vb),"i"(d0*4096+ks*1024):"memory");
      asm volatile("ds_read_b64_tr_b16 %0,%1 offset:%c2":"=&v"(hi[ks]):"v"(vb),"i"(d0*4096+ks*1024+512):"memory");}
    asm volatile("s_waitcnt lgkmcnt(0)":::"memory");SBAR();
    #define PK(k) (bf16x8){lo[k][0],lo[k][1],lo[k][2],lo[k][3],hi[k][0],hi[k][1],hi[k][2],hi[k][3]}
    o[d0]=__builtin_amdgcn_mfma_f32_32x32x16_bf16(pa0,PK(0),o[d0],0,0,0);
    o[d0]=__builtin_amdgcn_mfma_f32_32x32x16_bf16(pa1,PK(1),o[d0],0,0,0);
    o[d0]=__builtin_amdgcn_mfma_f32_32x32x16_bf16(pa2,PK(2),o[d0],0,0,0);
    o[d0]=__builtin_amdgcn_mfma_f32_32x32x16_bf16(pa3,PK(3),o[d0],0,0,0);
    #undef PK
  }
}

#ifndef ATTN_STORE16
#define ATTN_STORE16(p,v) (*(u32x4*)(p)=(v))
#endif
template<int THRL,int MODE,int LD> __device__ __forceinline__ void attn_unit(const bf16*Qw0,const bf16*__restrict__ Kh,const bf16*__restrict__ Vh,bf16*Gw0,const int NT,char*shm,const int relb0,const float sink2){
  const int tid=threadIdx.x,lane=tid&63,r32=lane&31,hi=lane>>5; const int wid=__builtin_amdgcn_readfirstlane(tid>>6);
  const bf16*Qw=Qw0+(long)(wid*QBLK)*LD;
  const unsigned lds0=(unsigned)(uintptr_t)shm;
  float*wsf=(float*)(shm+LDS_WS)+wid*64;
  const bf16*ksrc=Kh+(long)lane*LD+wid*8;
  const bf16*vsrc=Vh+(long)(16*(wid&3)+(lane>>2))*LD+(wid>>2)*32+(lane&3)*8;
  const unsigned kdst=lds0+LDS_K+wid*1024, vdst=lds0+LDS_V+wid*1024;
  #define DMA_K(t,slot) glds16(ksrc+(long)(t)*KVBLK*LD,(unsigned)__builtin_amdgcn_readfirstlane(kdst+(slot)))
  #define DMA_V(t,slot) glds16(vsrc+(long)(t)*KVBLK*LD,(unsigned)__builtin_amdgcn_readfirstlane(vdst+(slot)))
  const int vb0=(int)(lds0+LDS_V)+((lane>>4)&1)*32+(lane&3)*8+(4*hi+((lane&15)>>2))*64;
  const char*Kbase=shm+LDS_K; bf16x8 kf[8];
  const lds_cptr shm3=(lds_cptr)shm; const lds_cptr kp0=shm3+LDS_K+hi*1024+r32*16; const lds_cptr vp0=shm3+LDS_V+((lane>>4)&1)*32+(lane&3)*8+(4*hi+((lane&15)>>2))*64;
  DMA_K(0,0);DMA_V(0,0);DMA_K(1,SLOTB);
  bf16x8 qr[4];
  #pragma unroll
  for(int d0=0;d0<4;++d0)qr[d0]=*reinterpret_cast<const bf16x8*>(&Qw[(long)r32*LD+d0*16+hi*8]);
  float mhat=(MODE==1)?sink2:0.f,l_reg=(MODE==1&&hi==0)?1.f:0.f;f32x16 o[2];o[0]=f32x16{};o[1]=f32x16{};f32x16 negm;
  _Pragma("unroll") for(int r=0;r<16;++r)negm[r]=-mhat; asm volatile("":"+v"(negm));
  const __attribute__((address_space(3))) float* tabl=(const __attribute__((address_space(3))) float*)((lds_cptr)shm+LDS_TAB)+(relb0-wid*QBLK-r32+4*hi);
  #define CMASK(P0,P1,t) do{ if(MODE==1){ const __attribute__((address_space(3))) float* tp_=tabl+64*(t); \
      _Pragma("unroll") for(int r=0;r<16;++r){P0[r]+=tp_[(r&3)+8*(r>>2)];P1[r]+=tp_[32+(r&3)+8*(r>>2)];} } }while(0)
  bool resc=false;
  #define START(P0,P1) do{ const float rm=rowmax(P0,P1); resc=false; \
    { const float dl=(MODE==1)?__builtin_fmaxf(rm,0.f):rm; mhat=fadd_s(mhat,dl); if(MODE==1)l_reg*=__builtin_amdgcn_exp2f(-dl); \
      _Pragma("unroll") for(int r=0;r<16;++r){P0[r]=fsub_s(P0[r],dl);P1[r]=fsub_s(P1[r],dl);} \
      _Pragma("unroll") for(int r=0;r<16;++r)negm[r]=-mhat; asm volatile("":"+v"(negm)); } \
    _Pragma("unroll") for(int r=0;r<16;++r)P0[r]=__builtin_amdgcn_exp2f(P0[r]); }while(0)
  #define RESC() do{ if(resc){ asm volatile("s_waitcnt lgkmcnt(0)":::"memory"); \
      _Pragma("unroll") for(int d_=0;d_<2;++d_) _Pragma("unroll") for(int r=0;r<16;++r)o[d_][r]*=wsf[crow(r,hi)]; } }while(0)
  f32x16 pA0,pA1,pB0,pB1;
  int sl_prev=0,sl_cur=0,sl_next=SLOTB;
  #define ROT() do{sl_prev=sl_cur;sl_cur=sl_next;sl_next=(sl_next==(NSLOT-1)*SLOTB)?0:sl_next+SLOTB;}while(0)
  DMA_K(2,2*SLOTB);
  WAIT_BAR(3);
  qkt(pA0,pA1,Kbase,qr,negm,r32,hi);asm volatile("s_nop 15\n\ts_nop 7":"+v"(pA0),"+v"(pA1));CMASK(pA0,pA1,0);
  START(pA0,pA1);
  _Pragma("unroll") for(int r=0;r<16;++r)pA1[r]=__builtin_amdgcn_exp2f(pA1[r]);
  WAIT_BAR(0);
  DMA_K(3,0);DMA_V(1,SLOTB);
  ROT();
  kload8(kf,kp0+sl_cur);
  WAIT_BAR(2);
  s16x4 vlo[8],vhi[8]; u32x4 pw0,pw1,pw2,pw3;
  #define PKW(P,B) cvtpk_s(P[B],P[B+1])
  #define PAF(k) __builtin_bit_cast(bf16x8,pw##k)
  #define VFR(i) (bf16x8){vlo[i][0],vlo[i][1],vlo[i][2],vlo[i][3],vhi[i][0],vhi[i][1],vhi[i][2],vhi[i][3]}
  #define PIN(x) asm volatile("":"+v"(x))
  #define MX3(a,b,c) __builtin_fmaxf(__builtin_fmaxf((a),(b)),(c))
  #define GAPA(MF,A0,A1,A2,A3,W0,W1,PW) do{ MF; sacc+=A0; sacc+=A1; sacc+=A2; sacc+=A3; PIN(sacc); W0; W1; PIN(PW); SBAR(); }while(0)
  #define EX(v) __builtin_amdgcn_exp2f(v)
  #define GAPB(MF,X,B) do{ MF; X[B]=EX(X[B]); X[B+1]=EX(X[B+1]); X[B+2]=EX(X[B+2]); X[B+3]=EX(X[B+3]); PIN(X); SBAR(); }while(0)
  #define VRD(i) do{ vlo[i]=vtr(vp_+(((i)>>2)*4096+((i)&3)*1024)); vhi[i]=vtr(vp_+(((i)>>2)*4096+((i)&3)*1024+512)); }while(0)
  #define KRD(G,j) do{ if(G){ kload2(kf,kp0+sl_next,j); SBAR(); } }while(0)
  #define STEP(C0,C1,P0,P1,t,GK,GV,GL) do{ SBAR(); \
    const lds_cptr vp_=vp0+sl_prev; \
    VRD(0); SBAR(); float sacc=(P0[0]+P0[1]); \
    GAPA(C0=__builtin_amdgcn_mfma_f32_32x32x16_bf16(kf[0],qr[0],negm,0,0,0), P0[2],P0[3],P0[4],P0[5],     pw0[0]=PKW(P0,0), pw0[1]=PKW(P0,2), pw0); \
    VRD(4); SBAR(); GAPA(C1=__builtin_amdgcn_mfma_f32_32x32x16_bf16(kf[1],qr[0],negm,0,0,0), P0[6],P0[7],P0[8],P0[9],     pw0[2]=PKW(P0,4), pw0[3]=PKW(P0,6), pw0); \
    VRD(1); SBAR(); GAPA(C0=__builtin_amdgcn_mfma_f32_32x32x16_bf16(kf[2],qr[1],C0,0,0,0),   P0[10],P0[11],P0[12],P0[13], pw1[0]=PKW(P0,8), pw1[1]=PKW(P0,10), pw1); \
    VRD(5); SBAR(); GAPA(C1=__builtin_amdgcn_mfma_f32_32x32x16_bf16(kf[3],qr[1],C1,0,0,0),   P0[14],P0[15],P1[0],P1[1],   pw1[2]=PKW(P0,12),pw1[3]=PKW(P0,14), pw1); \
    VRD(2); SBAR(); GAPA(C0=__builtin_amdgcn_mfma_f32_32x32x16_bf16(kf[4],qr[2],C0,0,0,0),   P1[2],P1[3],P1[4],P1[5],     pw2[0]=PKW(P1,0), pw2[1]=PKW(P1,2), pw2); \
    VRD(6); SBAR(); GAPA(C1=__builtin_amdgcn_mfma_f32_32x32x16_bf16(kf[5],qr[2],C1,0,0,0),   P1[6],P1[7],P1[8],P1[9],     pw2[2]=PKW(P1,4), pw2[3]=PKW(P1,6), pw2); \
    VRD(3); SBAR(); GAPA(C0=__builtin_amdgcn_mfma_f32_32x32x16_bf16(kf[6],qr[3],C0,0,0,0),   P1[10],P1[11],P1[12],P1[13], pw3[0]=PKW(P1,8), pw3[1]=PKW(P1,10), pw3); \
    VRD(7); SBAR(); GAPA(C1=__builtin_amdgcn_mfma_f32_32x32x16_bf16(kf[7],qr[3],C1,0,0,0),   P1[14],P1[15],0.f,0.f,       pw3[2]=PKW(P1,12),pw3[3]=PKW(P1,14), pw3); \
    l_reg+=sacc; \
    if(GK){DMA_K((t)+3,sl_cur);} if(GV){DMA_V((t)+1,sl_next);} \
    CMASK(C0,C1,t); \
    { float a=MX3(C0[0],C0[1],C1[0]),b=MX3(C0[2],C0[3],C1[1]); a=MX3(a,C1[2],C1[3]); \
      _Pragma("unroll") for(int r=4;r<16;r+=4){a=MX3(a,C0[r],C0[r+1]);b=MX3(b,C0[r+2],C0[r+3]);a=MX3(a,C1[r],C1[r+1]);b=MX3(b,C1[r+2],C1[r+3]);} \
      float rm=__builtin_fmaxf(a,b); { auto rr=__builtin_amdgcn_permlane32_swap(__float_as_uint(rm),__float_as_uint(rm),false,false); rm=__builtin_fmaxf(__uint_as_float(rr[0]),__uint_as_float(rr[1])); } \
      resc=false; \
      if(__builtin_expect(__any(rm>(float)THRL),0)){ const float dl=__builtin_fmaxf(rm,0.f); mhat+=dl; \
        _Pragma("unroll") for(int r=0;r<16;++r){C0[r]-=dl;C1[r]-=dl;} \
        _Pragma("unroll") for(int r=0;r<16;++r)negm[r]=-mhat; asm volatile("":"+v"(negm)); \
        const float f=__builtin_amdgcn_exp2f(-dl); l_reg*=f; if(hi==0)wsf[r32]=f; resc=true; } } \
    SBAR(); \
    GAPB(o[0]=__builtin_amdgcn_mfma_f32_32x32x16_bf16(PAF(0),VFR(0),o[0],0,0,0), C0,0); \
    GAPB(o[1]=__builtin_amdgcn_mfma_f32_32x32x16_bf16(PAF(0),VFR(4),o[1],0,0,0), C0,4); \
    KRD(GL,0); GAPB(o[0]=__builtin_amdgcn_mfma_f32_32x32x16_bf16(PAF(1),VFR(1),o[0],0,0,0), C0,8); \
    KRD(GL,1); GAPB(o[1]=__builtin_amdgcn_mfma_f32_32x32x16_bf16(PAF(1),VFR(5),o[1],0,0,0), C0,12); \
    KRD(GL,2); GAPB(o[0]=__builtin_amdgcn_mfma_f32_32x32x16_bf16(PAF(2),VFR(2),o[0],0,0,0), C1,0); \
    KRD(GL,3); GAPB(o[1]=__builtin_amdgcn_mfma_f32_32x32x16_bf16(PAF(2),VFR(6),o[1],0,0,0), C1,4); \
    GAPB(o[0]=__builtin_amdgcn_mfma_f32_32x32x16_bf16(PAF(3),VFR(3),o[0],0,0,0), C1,8); \
    GAPB(o[1]=__builtin_amdgcn_mfma_f32_32x32x16_bf16(PAF(3),VFR(7),o[1],0,0,0), C1,12); \
    }while(0)
  int t=1;
  for(;t+5<NT;t+=2){
    STEP(pB0,pB1,pA0,pA1,t,true,true,true);     WAIT_BAR(2); RESC(); ROT();
    STEP(pA0,pA1,pB0,pB1,t+1,true,true,true);   WAIT_BAR(2); RESC(); ROT();
  }
  #define ENDW(tt) do{ if((tt)+3<NT){WAIT_BAR(2);} else if((tt)+2<NT){WAIT_BAR(1);} else {WAIT_BAR(0);} }while(0)
  for(;t+1<NT;t+=2){
    STEP(pB0,pB1,pA0,pA1,t,(t+3<NT),(t+1<NT),(t+1<NT));       ENDW(t);   RESC(); ROT();
    STEP(pA0,pA1,pB0,pB1,t+1,(t+4<NT),(t+2<NT),(t+2<NT));     ENDW(t+1); RESC(); ROT();
  }
  STEP(pB0,pB1,pA0,pA1,NT-1,false,false,false); RESC();
  { float sacc=pB0[0]+pB0[1]; _Pragma("unroll") for(int r=2;r<16;++r)sacc+=pB0[r]; _Pragma("unroll") for(int r=0;r<16;++r)sacc+=pB1[r]; l_reg+=sacc;
    pw0=(u32x4){PKW(pB0,0),PKW(pB0,2),PKW(pB0,4),PKW(pB0,6)};pw1=(u32x4){PKW(pB0,8),PKW(pB0,10),PKW(pB0,12),PKW(pB0,14)};pw2=(u32x4){PKW(pB1,0),PKW(pB1,2),PKW(pB1,4),PKW(pB1,6)};pw3=(u32x4){PKW(pB1,8),PKW(pB1,10),PKW(pB1,12),PKW(pB1,14)};
    SBAR(); pv(o,vb0+sl_cur,PAF(0),PAF(1),PAF(2),PAF(3)); }
  #undef PKW
  #undef PAF
  #undef VFR
  #undef PIN
  #undef MX3
  #undef GAPA
  #undef GAPB
  #undef EX
  #undef VRD
  #undef KRD
  #undef STEP
  #undef ENDW
  {auto rr=__builtin_amdgcn_permlane32_swap(__float_as_uint(l_reg),__float_as_uint(l_reg),false,false);l_reg=__uint_as_float(rr[0])+__uint_as_float(rr[1]);}
  if(hi==0)wsf[32+r32]=l_reg;asm volatile("s_waitcnt lgkmcnt(0)":::"memory");
  float rli[16];
  #pragma unroll
  for(int r=0;r<16;++r)rli[r]=__builtin_amdgcn_rcpf(wsf[32+crow(r,hi)]);
  bf16*Ow=Gw0+(long)(wid*QBLK)*LD;
  { bf16*stg=(bf16*)(shm+LDS_OST)+wid*2048;
    #pragma unroll
    for(int r=0;r<16;++r){const int orow=crow(r,hi);
      #pragma unroll
      for(int d0=0;d0<2;++d0)stg[orow*64+d0*32+r32]=__float2bfloat16(o[d0][r]*rli[r]);}
    asm volatile("s_waitcnt lgkmcnt(0)":::"memory");
    #pragma unroll
    for(int i=0;i<4;++i){const int row=i*8+(lane>>3),ch=lane&7; const u32x4 v=*(const u32x4*)(stg+row*64+ch*8); const u32x4 g=*(const u32x4*)(Ow+(long)row*LD+ch*8); u32x4 w;
      _Pragma("unroll") for(int e=0;e<4;++e){ w[e]=cvtpk_s(__builtin_bit_cast(float,v[e]<<16)*__builtin_bit_cast(float,g[e]<<16), __builtin_bit_cast(float,v[e]&0xffff0000u)*__builtin_bit_cast(float,g[e]&0xffff0000u)); }
      ATTN_STORE16(Ow+(long)row*LD+ch*8,w);} }
  asm volatile("s_waitcnt lgkmcnt(0)\n\ts_barrier":::"memory");
  #undef DMA_K
  #undef DMA_V
  #undef CMASK
  #undef START
  #undef RESC
  #undef ROT
}
constexpr int ATTN_LDS_BYTES=LDS_BYTES;
#undef SBAR
#undef WAIT_BAR
}

constexpr int NWAVES = 8;
constexpr int DM = 1024, MROWS = 32768, MP = 16384;
constexpr int NAB = 2816, NCC = 2304;
constexpr float EPS = 1e-6f, LOG2E = 1.4426950408889634f, QSCALE = 0.125f * 1.4426950408889634f;
constexpr int ZA_Q = 0, ZA_K = 512, ZA_V = 640, ZB_Q = 768, ZB_K = 1024, ZB_V = 1280, ZA_G = 1792, ZB_G = 2304;
constexpr int ZC_Q = 0, ZC_K = 1024, ZC_V = 1152, ZC_G = 1280;

constexpr size_t MiB = 1u << 20;
constexpr size_t WS_CTL = 0, CTL_ZERO_BYTES = 64 * 1024;
constexpr size_t WS_AXT = 1 * MiB;
constexpr size_t WS_LINT = 1 * MiB + 65536;
constexpr size_t WS_PART1 = 3 * MiB, WS_PART2 = 5 * MiB;
constexpr size_t WS_WOAB = 7 * MiB, WS_WC = 9 * MiB, WS_WOC = 14 * MiB;
constexpr size_t WS_Z = 16 * MiB;
constexpr size_t WS_B = 192 * MiB;
constexpr size_t WS_END = 256 * MiB;
constexpr size_t OUT_XN = 0, OUT_WAB = 64 * MiB;

constexpr int CW_BAR = 1024;

constexpr int RING_OFF = 0, RING_BYTES = 131072;
constexpr int LDSCTL_OFF = RING_BYTES, MISC_OFF = LDSCTL_OFF + 320;
constexpr int LDS_BYTES = 147456;

#define GAS __attribute__((address_space(1)))
#define LAS __attribute__((address_space(3)))
typedef unsigned short bf16;
typedef unsigned v4u __attribute__((ext_vector_type(4)));
typedef float f32x4 __attribute__((ext_vector_type(4)));
typedef float f32x2 __attribute__((ext_vector_type(2)));
#define LDS_WAIT() asm volatile("s_waitcnt lgkmcnt(0)" ::: "memory")
#define VM_WAIT() asm volatile("s_waitcnt vmcnt(0)" ::: "memory")
__device__ __forceinline__ unsigned f2bf(float f) { unsigned u = __builtin_bit_cast(unsigned, f); return (u + 0x7fffu + ((u >> 16) & 1u)) >> 16; }
__device__ __forceinline__ unsigned pk2(float lo, float hi) { return f2bf(lo) | (f2bf(hi) << 16); }
__device__ __forceinline__ float bf_lo(unsigned w) { return __builtin_bit_cast(float, w << 16); }
__device__ __forceinline__ float bf_hi(unsigned w) { return __builtin_bit_cast(float, w & 0xffff0000u); }
__device__ __forceinline__ int seq_pos(int row) { return row < MP ? (row & 4095) : (row & 2047); }
__device__ __forceinline__ float silu_f(float v) { return v * __builtin_amdgcn_rcpf(1.f + __builtin_amdgcn_exp2f(-v * LOG2E)); }

#define XB_TMO      128
#define XB_XCNT(j)  (256  + 64 * (j))
#define XB_XSUB(j)  (1280 + 64 * (j))
#define XB_XGEN(j)  (2304 + 64 * (j))
#define XB_TOP      3328
#define XB_TOPGEN   3392
#define XCD_BAR_WORDS 3456
#define XB_SPIN_CAP (1u << 18)
__device__ __forceinline__ unsigned xb_ld(unsigned* p)              { return __hip_atomic_load(p, __ATOMIC_RELAXED, __HIP_MEMORY_SCOPE_AGENT); }
__device__ __forceinline__ unsigned xb_add(unsigned* p, unsigned v) { return __hip_atomic_fetch_add(p, v, __ATOMIC_RELAXED, __HIP_MEMORY_SCOPE_AGENT); }
__device__ __forceinline__ unsigned xb_xcc_id() { return (unsigned)__builtin_amdgcn_s_getreg((3 << 11) | 20) & 0xFu; }
#define XB_SPIN(cond, bar) do { unsigned _sp = 0; while (cond) { __builtin_amdgcn_s_sleep(1); \
    if ((++_sp & 255u) == 0u) { if (xb_ld(&(bar)[XB_TMO])) break; if (_sp > XB_SPIN_CAP) { atomicAdd(&(bar)[XB_TMO], 1u); break; } } } } while (0)
struct XcdBarrier { unsigned* bar; unsigned x; volatile LAS unsigned* st; };
__device__ __forceinline__ XcdBarrier xcd_barrier_post(unsigned* bar, volatile LAS unsigned* st) {
    XcdBarrier b; b.bar = bar; b.x = xb_xcc_id(); b.st = st;
    if (threadIdx.x == 0) (void)xb_add(&bar[XB_XCNT(b.x)], 1u);
    return b;
}
__device__ __forceinline__ void xcd_barrier_complete(unsigned* bar, unsigned x, unsigned& nloc, unsigned& nx) {
    const unsigned G = gridDim.x * gridDim.y * gridDim.z;
    unsigned sum, cnt, mine, sp = 0u;
    for (;;) {
        sum = 0u; cnt = 0u; mine = 0u;
#pragma unroll
        for (unsigned j = 0; j < 16; ++j) { const unsigned c = xb_ld(&bar[XB_XCNT(j)]); sum += c; cnt += (c > 0u) ? 1u : 0u; mine = (j == x) ? c : mine; }
        if (sum == G) break;
        __builtin_amdgcn_s_sleep(1);
        if ((++sp & 255u) == 0u) { if (xb_ld(&bar[XB_TMO])) break; if (sp > XB_SPIN_CAP) { atomicAdd(&bar[XB_TMO], 1u); break; } }
    }
    nloc = mine > 0u ? mine : 1u; nx = cnt > 0u ? cnt : 1u;
}
__device__ __forceinline__ void xcd_barrier(const XcdBarrier& b) {
    asm volatile("s_waitcnt vmcnt(0)" ::: "memory");
    __syncthreads();
    if (threadIdx.x == 0) {
        unsigned* bar = b.bar;
        __builtin_amdgcn_s_waitcnt(0);
        unsigned nloc = b.st[0], nx = b.st[1];
        if (nloc == 0u) { xcd_barrier_complete(bar, b.x, nloc, nx); b.st[0] = nloc; b.st[1] = nx; }
        const unsigned old = xb_add(&bar[XB_XSUB(b.x)], 1u);
        const unsigned gen = old / nloc;
        if (old + 1u == (gen + 1u) * nloc) {
            __builtin_amdgcn_fence(__ATOMIC_RELEASE, "agent");
            asm volatile("s_waitcnt vmcnt(0)" ::: "memory");
            const unsigned og = xb_add(&bar[XB_TOP], 1u);
            const unsigned tg = og / nx;
            if (og + 1u == (tg + 1u) * nx) xb_add(&bar[XB_TOPGEN], 1u);
            else XB_SPIN(xb_ld(&bar[XB_TOPGEN]) == tg, bar);
            __builtin_amdgcn_fence(__ATOMIC_ACQUIRE, "agent");
            xb_add(&bar[XB_XGEN(b.x)], 1u);
            asm volatile("s_waitcnt vmcnt(0)" ::: "memory");
        } else {
            XB_SPIN(xb_ld(&bar[XB_XGEN(b.x)]) == gen, bar);
            __builtin_amdgcn_fence(__ATOMIC_ACQUIRE, "agent");
            asm volatile("s_waitcnt vmcnt(0)" ::: "memory");
        }
    }
    __syncthreads();
}

using pg8::Unit; using pg8::cvt_pk_bf16;
__device__ __forceinline__ f32x4 rot4(f32x4 y, f32x4 cs) { return (f32x4){y.x * cs.x - y.y * cs.y, y.x * cs.y + y.y * cs.x, y.z * cs.z - y.w * cs.w, y.z * cs.w + y.w * cs.z}; }
__device__ __forceinline__ f32x4 silu4(f32x4 v) { return (f32x4){silu_f(v.x), silu_f(v.y), silu_f(v.z), silu_f(v.w)}; }
__device__ __forceinline__ v4u pack8(f32x4 a, f32x4 b) { v4u w; w.x = cvt_pk_bf16(a.x, a.y); w.y = cvt_pk_bf16(a.z, a.w); w.z = cvt_pk_bf16(b.x, b.y); w.w = cvt_pk_bf16(b.z, b.w); return w; }

struct EpiInAB {
    static constexpr bool AFTER_DRAIN = false;
    bf16* Z; const float* gain; const float* axtab; const float* lintab;
    __device__ __forceinline__ void operator()(const f32x4 (&acc)[2][2][4][2], const Unit& u, int wr, int wc, int fr, int fq) const {
        const int pn = u.pn;
        int kind;
        if (pn < 2) kind = 1; else if (pn == 2) kind = (wc < 2) ? 2 : 0; else if (pn == 3) kind = 3; else if (pn == 4) kind = 4; else if (pn < 7) kind = 0; else kind = 5;
        const int colw = pn * 256 + wc * 64 + fq * 8;
        f32x4 gv[2][2];
        if (kind == 1 || kind == 2) {
            const float* gp = gain + (kind == 2 ? 64 : 0);
#pragma unroll
            for (int bj = 0; bj < 2; ++bj)
#pragma unroll
                for (int n = 0; n < 2; ++n) gv[bj][n] = *(const f32x4*)(gp + bj * 32 + fq * 8 + n * 4);
        }
#pragma unroll
        for (int ai = 0; ai < 2; ++ai)
#pragma unroll
            for (int m = 0; m < 4; ++m) {
                const int row = u.pm * 256 + ai * 128 + wr * 64 + m * 16 + fr; const int t = seq_pos(row);
                f32x4 v[2][2];
#pragma unroll
                for (int bj = 0; bj < 2; ++bj)
#pragma unroll
                    for (int n = 0; n < 2; ++n) v[bj][n] = acc[ai][bj][m][n];
                if (kind == 1 || kind == 2) {
                    float ss = 0.f;
#pragma unroll
                    for (int bj = 0; bj < 2; ++bj)
#pragma unroll
                        for (int n = 0; n < 2; ++n) { const f32x4 x = v[bj][n]; ss += (x.x * x.x + x.y * x.y) + (x.z * x.z + x.w * x.w); }
                    ss += __shfl_xor(ss, 16); ss += __shfl_xor(ss, 32);
                    const float rinv = rsqrtf(ss * (1.f / 64.f) + EPS) ;
                    const float sc = (kind == 1) ? QSCALE : 1.f;
#pragma unroll
                    for (int bj = 0; bj < 2; ++bj) { const int pos = bj == 0 ? (t >> 6) : (t & 63);
#pragma unroll
                        for (int n = 0; n < 2; ++n) { const f32x4 cs = *(const f32x4*)(axtab + (pos * 16 + 4 * fq + 2 * n) * 2);
                            v[bj][n] = rot4(v[bj][n] * rinv * gv[bj][n], cs) * sc; } }
                } else if (kind == 3 || kind == 4) {
                    const float sc = (kind == 4) ? 0.125f : 1.f;
#pragma unroll
                    for (int bj = 0; bj < 2; ++bj)
#pragma unroll
                        for (int n = 0; n < 2; ++n) { const f32x4 cs = *(const f32x4*)(lintab + ((size_t)t * 32 + 16 * bj + 4 * fq + 2 * n) * 2);
                            v[bj][n] = rot4(v[bj][n], cs) * sc; }
                } else if (kind == 5) {
#pragma unroll
                    for (int bj = 0; bj < 2; ++bj)
#pragma unroll
                        for (int n = 0; n < 2; ++n) v[bj][n] = silu4(v[bj][n]);
                }
                bf16* rowp = Z + (size_t)row * NAB + colw;
#pragma unroll
                for (int bj = 0; bj < 2; ++bj) *(v4u*)(rowp + bj * 32) = pack8(v[bj][0], v[bj][1]);
            }
    }
};
struct EpiOut {
    static constexpr bool AFTER_DRAIN = false;
    const float* base0; const float* base1;
    float* out; bf16* xbf; float* part;
    __device__ __forceinline__ void operator()(const f32x4 (&acc)[2][2][4][2], const Unit& u, int wr, int wc, int fr, int fq) const {
        const int colw = u.pn * 256 + wc * 64 + fq * 8;
#pragma unroll
        for (int ai = 0; ai < 2; ++ai)
#pragma unroll
            for (int m = 0; m < 4; ++m) {
                const int row = u.pm * 256 + ai * 128 + wr * 64 + m * 16 + fr;
                const float* bp = (row < MP ? base0 + (size_t)row * DM : base1 + (size_t)(row - MP) * DM) + colw;
                float* op = out + (size_t)row * DM + colw;
                float ss = 0.f; f32x4 o[2][2];
#pragma unroll
                for (int bj = 0; bj < 2; ++bj)
#pragma unroll
                    for (int n = 0; n < 2; ++n) { const f32x4 b = *(const f32x4*)(bp + bj * 32 + n * 4); const f32x4 x = b + acc[ai][bj][m][n]; o[bj][n] = x;
                        ss += (x.x * x.x + x.y * x.y) + (x.z * x.z + x.w * x.w); }
#pragma unroll
                for (int bj = 0; bj < 2; ++bj)
#pragma unroll
                    for (int n = 0; n < 2; ++n) *(f32x4*)(op + bj * 32 + n * 4) = o[bj][n];
                if (xbf) {
#pragma unroll
                    for (int bj = 0; bj < 2; ++bj) *(v4u*)(xbf + (size_t)row * DM + colw + bj * 32) = pack8(o[bj][0], o[bj][1]);
                }
                ss += __shfl_xor(ss, 16); ss += __shfl_xor(ss, 32);
                if (fq == 0) part[(size_t)row * 16 + u.pn * 4 + wc] = ss;
            }
    }
};
struct EpiInC {
    static constexpr bool AFTER_DRAIN = false;
    bf16* Z; const float* part;
    __device__ __forceinline__ void operator()(const f32x4 (&acc)[2][2][4][2], const Unit& u, int wr, int wc, int fr, int fq) const {
        const int pn = u.pn; const int kind = pn < 4 ? 1 : (pn == 4 ? 0 : 5);
        const int colw = pn * 256 + wc * 64 + fq * 8;
#pragma unroll
        for (int ai = 0; ai < 2; ++ai)
#pragma unroll
            for (int m = 0; m < 4; ++m) {
                const int row = u.pm * 256 + ai * 128 + wr * 64 + m * 16 + fr;
                const f32x4* pp = (const f32x4*)(part + (size_t)row * 16);
                const f32x4 p0 = pp[0], p1 = pp[1], p2 = pp[2], p3 = pp[3];
                const float s = ((p0.x + p0.y) + (p0.z + p0.w)) + ((p1.x + p1.y) + (p1.z + p1.w)) + ((p2.x + p2.y) + (p2.z + p2.w)) + ((p3.x + p3.y) + (p3.z + p3.w));
                float rstd = rsqrtf(s * (1.f / DM) + EPS); if (kind == 1) rstd *= QSCALE;
                bf16* rowp = Z + (size_t)row * NCC + colw;
#pragma unroll
                for (int bj = 0; bj < 2; ++bj) { f32x4 a = acc[ai][bj][m][0] * rstd, b = acc[ai][bj][m][1] * rstd;
                    if (kind == 5) { a = silu4(a); b = silu4(b); }
                    *(v4u*)(rowp + bj * 32) = pack8(a, b); }
            }
    }
};

struct Frame {
    LAS unsigned char* lds;
    volatile LAS unsigned* MISC;
    int tid, lane, wave, vcu, G;
};
__device__ __forceinline__ float wave_sum(float v) {
#pragma unroll
    for (int o = 1; o < 64; o <<= 1) v += __shfl_xor(v, o);
    return v;
}
__device__ __forceinline__ int remap_ab(int n0) { return n0 < 768 ? n0 : (n0 < 1280 ? n0 + 1024 : (n0 < 2304 ? n0 - 512 : n0)); }
__device__ __forceinline__ void p0_transpose_item(const float* W, int K, int N, const float* g, bool remap, bf16* WT, LAS float* scr, int item, int lane) {
    const int nblk = N / 32, kb = item / nblk, nb = item % nblk, k0 = 64 * kb, n0 = 32 * nb;
    const int d0 = remap ? remap_ab(n0) : n0;
#pragma unroll 8
    for (int i = 0; i < 32; ++i) { const int kk = 2 * i + (lane >> 5); const float gs = g ? g[k0 + kk] : 1.f; scr[kk * 33 + (lane & 31)] = W[(size_t)(k0 + kk) * N + n0 + (lane & 31)] * gs; }
    LDS_WAIT(); asm volatile("" ::: "memory");
    const int c = lane & 7;
#pragma unroll
    for (int j = 0; j < 4; ++j) { const int n = (lane >> 3) + 8 * j; const LAS float* s = scr + (8 * c) * 33 + n;
        v4u o; o.x = pk2(s[0 * 33], s[1 * 33]); o.y = pk2(s[2 * 33], s[3 * 33]); o.z = pk2(s[4 * 33], s[5 * 33]); o.w = pk2(s[6 * 33], s[7 * 33]);
        *(GAS v4u*)(WT + (size_t)(d0 + n) * K + k0 + 8 * c) = o; }
    LDS_WAIT(); asm volatile("" ::: "memory");
}
__device__ __forceinline__ void rms_row_to_bf16(int lane, const float* xrow, bf16* orow) {
    const GAS f32x4* xr = (const GAS f32x4*)xrow + lane;
    f32x4 v[4]; float s = 0.f;
#pragma unroll
    for (int j = 0; j < 4; ++j) { v[j] = xr[64 * j]; s += (v[j].x * v[j].x + v[j].y * v[j].y) + (v[j].z * v[j].z + v[j].w * v[j].w); }
    const float rstd = rsqrtf(wave_sum(s) * (1.f / DM) + EPS);
    GAS unsigned long long* o8 = (GAS unsigned long long*)orow + lane;
#pragma unroll
    for (int j = 0; j < 4; ++j) o8[64 * j] = (unsigned long long)pk2(v[j].x * rstd, v[j].y * rstd) | ((unsigned long long)pk2(v[j].z * rstd, v[j].w * rstd) << 32);
}

__device__ __forceinline__ int t5_bucket(int rel) {
    const int d = rel < 0 ? -rel : rel; int b;
    if (d < 8) b = d; else if (d < 12) b = 8; else if (d < 16) b = 9; else if (d < 23) b = 10; else if (d < 32) b = 11; else if (d < 46) b = 12; else if (d < 64) b = 13; else if (d < 91) b = 14; else b = 15;
    return b + (rel > 0 ? 16 : 0);
}
template <int MODE> __device__ __forceinline__ void sc_attn_item(Frame& F, bf16* Z, int item, const float* sink, const float* rel_bias) {
    constexpr int LD = MODE == 0 ? NAB : NCC;
    const int h = item >> 6, bq = item & 63, row0 = bq * 512;
    const int sbase = row0 < MP ? (row0 & ~4095) : (MP + ((row0 - MP) & ~2047)), slen = row0 < MP ? 4096 : 2048;
    const int qcol = (MODE == 0 ? ZA_Q : ZC_Q) + h * 64, kcol = MODE == 0 ? ZA_K + (h >> 2) * 64 : ZC_K + (h >> 3) * 64, vcol = MODE == 0 ? ZA_V + (h >> 2) * 64 : ZC_V + (h >> 3) * 64;
    const int gcol = (MODE == 0 ? ZA_G : ZC_G) + h * 64;
    LAS float* Kt = (LAS float*)(F.lds + RING_OFF); LAS float* Vt = Kt + 64 * 64; LAS float* tab = Vt + 64 * 64;
    const int row = row0 + F.tid, ipos = row - sbase;
    float q[64], o[64];
    { const v4u* qp = (const v4u*)(Z + (size_t)row * LD + qcol);
#pragma unroll
      for (int c = 0; c < 8; ++c) { const v4u w = qp[c]; q[8 * c + 0] = bf_lo(w.x); q[8 * c + 1] = bf_hi(w.x); q[8 * c + 2] = bf_lo(w.y); q[8 * c + 3] = bf_hi(w.y); q[8 * c + 4] = bf_lo(w.z); q[8 * c + 5] = bf_hi(w.z); q[8 * c + 6] = bf_lo(w.w); q[8 * c + 7] = bf_hi(w.w); } }
#pragma unroll
    for (int d = 0; d < 64; ++d) o[d] = 0.f;
    float mrun = -1e30f, lrun = 0.f;
    int k_lo = 0, k_hi = slen;
    if (MODE == 1) {
        __syncthreads();
        if (F.tid < 257) tab[F.tid] = rel_bias[t5_bucket(F.tid - 128) * 16 + h] * LOG2E;
        mrun = sink[h] * LOG2E; lrun = 1.f;
        const int p0 = row0 - sbase; k_lo = p0 - 128 < 0 ? 0 : p0 - 128; k_hi = p0 + 512 + 128 > slen ? slen : p0 + 512 + 128;
    }
    for (int k0 = k_lo; k0 < k_hi; k0 += 64) {
        __syncthreads();
        { const int key = F.tid >> 3, ch = F.tid & 7; const bf16* rp = Z + (size_t)(sbase + k0 + key) * LD;
          const v4u kw = *(const v4u*)(rp + kcol + ch * 8), vw = *(const v4u*)(rp + vcol + ch * 8);
          LAS float* kd = Kt + key * 64 + ch * 8; LAS float* vd = Vt + key * 64 + ch * 8;
          kd[0] = bf_lo(kw.x); kd[1] = bf_hi(kw.x); kd[2] = bf_lo(kw.y); kd[3] = bf_hi(kw.y); kd[4] = bf_lo(kw.z); kd[5] = bf_hi(kw.z); kd[6] = bf_lo(kw.w); kd[7] = bf_hi(kw.w);
          vd[0] = bf_lo(vw.x); vd[1] = bf_hi(vw.x); vd[2] = bf_lo(vw.y); vd[3] = bf_hi(vw.y); vd[4] = bf_lo(vw.z); vd[5] = bf_hi(vw.z); vd[6] = bf_lo(vw.w); vd[7] = bf_hi(vw.w); }
        __syncthreads();
        for (int j = 0; j < 64; ++j) {
            const int rel = k0 + j - ipos;
            if (MODE == 1 && (rel > 128 || rel < -128)) continue;
            const LAS f32x4* kr = (const LAS f32x4*)(Kt + j * 64);
            float s0 = 0.f, s1 = 0.f, s2 = 0.f, s3 = 0.f;
#pragma unroll
            for (int c = 0; c < 16; ++c) { const f32x4 kv = kr[c]; s0 += q[4 * c] * kv.x; s1 += q[4 * c + 1] * kv.y; s2 += q[4 * c + 2] * kv.z; s3 += q[4 * c + 3] * kv.w; }
            float s = (s0 + s1) + (s2 + s3);
            if (MODE == 1) s += tab[rel + 128];
            const float mn = fmaxf(mrun, s), al = __builtin_amdgcn_exp2f(mrun - mn), p = __builtin_amdgcn_exp2f(s - mn);
            mrun = mn; lrun = lrun * al + p;
            const LAS f32x4* vr = (const LAS f32x4*)(Vt + j * 64);
#pragma unroll
            for (int c = 0; c < 16; ++c) { const f32x4 vv = vr[c]; o[4 * c] = o[4 * c] * al + p * vv.x; o[4 * c + 1] = o[4 * c + 1] * al + p * vv.y; o[4 * c + 2] = o[4 * c + 2] * al + p * vv.z; o[4 * c + 3] = o[4 * c + 3] * al + p * vv.w; }
        }
    }
    const float il = 1.f / lrun;
    v4u* gp = (v4u*)(Z + (size_t)row * LD + gcol);
#pragma unroll
    for (int c = 0; c < 8; ++c) { const v4u g = gp[c]; v4u w;
        w.x = pk2(o[8 * c + 0] * il * bf_lo(g.x), o[8 * c + 1] * il * bf_hi(g.x)); w.y = pk2(o[8 * c + 2] * il * bf_lo(g.y), o[8 * c + 3] * il * bf_hi(g.y));
        w.z = pk2(o[8 * c + 4] * il * bf_lo(g.z), o[8 * c + 5] * il * bf_hi(g.z)); w.w = pk2(o[8 * c + 6] * il * bf_lo(g.w), o[8 * c + 7] * il * bf_hi(g.w)); gp[c] = w; }
}
__device__ __forceinline__ void sc_ret_item(Frame& F, bf16* Z, int item, const float* ret_decay) {
    const int h = item >> 7, bq = item & 127, row0 = bq * 256;
    const int sbase = row0 < MP ? (row0 & ~4095) : (MP + ((row0 - MP) & ~2047)), slen = row0 < MP ? 4096 : 2048;
    const int qcol = ZB_Q + h * 64, kcol = ZB_K + h * 64, vcol = ZB_V + h * 128, gcol = ZB_G + h * 128;
    LAS float* Kt = (LAS float*)(F.lds + RING_OFF); LAS float* Vt = Kt + 64 * 64;
    const int row = row0 + (F.tid >> 1), half = F.tid & 1, ipos = row - sbase;
    const float lgf = -__expf(ret_decay[h]) * LOG2E, lgb = -__expf(ret_decay[4 + h]) * LOG2E;
    float q[64], o[64];
    { const v4u* qp = (const v4u*)(Z + (size_t)row * NAB + qcol);
#pragma unroll
      for (int c = 0; c < 8; ++c) { const v4u w = qp[c]; q[8 * c + 0] = bf_lo(w.x); q[8 * c + 1] = bf_hi(w.x); q[8 * c + 2] = bf_lo(w.y); q[8 * c + 3] = bf_hi(w.y); q[8 * c + 4] = bf_lo(w.z); q[8 * c + 5] = bf_hi(w.z); q[8 * c + 6] = bf_lo(w.w); q[8 * c + 7] = bf_hi(w.w); } }
#pragma unroll
    for (int d = 0; d < 64; ++d) o[d] = 0.f;
    for (int k0 = 0; k0 < slen; k0 += 64) {
        __syncthreads();
        { const int key = F.tid >> 3, ch = F.tid & 7; const bf16* rp = Z + (size_t)(sbase + k0 + key) * NAB;
          const v4u kw = *(const v4u*)(rp + kcol + ch * 8), vw = *(const v4u*)(rp + vcol + ch * 8), vw2 = *(const v4u*)(rp + vcol + 64 + ch * 8);
          LAS float* kd = Kt + key * 64 + ch * 8; LAS float* vd = Vt + key * 128 + ch * 8; LAS float* vd2 = vd + 64;
          kd[0] = bf_lo(kw.x); kd[1] = bf_hi(kw.x); kd[2] = bf_lo(kw.y); kd[3] = bf_hi(kw.y); kd[4] = bf_lo(kw.z); kd[5] = bf_hi(kw.z); kd[6] = bf_lo(kw.w); kd[7] = bf_hi(kw.w);
          vd[0] = bf_lo(vw.x); vd[1] = bf_hi(vw.x); vd[2] = bf_lo(vw.y); vd[3] = bf_hi(vw.y); vd[4] = bf_lo(vw.z); vd[5] = bf_hi(vw.z); vd[6] = bf_lo(vw.w); vd[7] = bf_hi(vw.w);
          vd2[0] = bf_lo(vw2.x); vd2[1] = bf_hi(vw2.x); vd2[2] = bf_lo(vw2.y); vd2[3] = bf_hi(vw2.y); vd2[4] = bf_lo(vw2.z); vd2[5] = bf_hi(vw2.z); vd2[6] = bf_lo(vw2.w); vd2[7] = bf_hi(vw2.w); }
        __syncthreads();
        for (int j = 0; j < 64; ++j) {
            const int d = ipos - (k0 + j);
            const float w = d >= 0 ? __builtin_amdgcn_exp2f(lgf * (float)d) : __builtin_amdgcn_exp2f(lgb * (float)(-d));
            const LAS f32x4* kr = (const LAS f32x4*)(Kt + j * 64);
            float s0 = 0.f, s1 = 0.f, s2 = 0.f, s3 = 0.f;
#pragma unroll
            for (int c = 0; c < 16; ++c) { const f32x4 kv = kr[c]; s0 += q[4 * c] * kv.x; s1 += q[4 * c + 1] * kv.y; s2 += q[4 * c + 2] * kv.z; s3 += q[4 * c + 3] * kv.w; }
            const float s = ((s0 + s1) + (s2 + s3)) * w;
            const LAS f32x4* vr = (const LAS f32x4*)(Vt + j * 128 + half * 64);
#pragma unroll
            for (int c = 0; c < 16; ++c) { const f32x4 vv = vr[c]; o[4 * c] += s * vv.x; o[4 * c + 1] += s * vv.y; o[4 * c + 2] += s * vv.z; o[4 * c + 3] += s * vv.w; }
        }
    }
    float ss = 0.f;
#pragma unroll
    for (int d = 0; d < 64; ++d) ss += o[d] * o[d];
    ss += __shfl_xor(ss, 1);
    const float r = rsqrtf(ss * (1.f / 128.f) + EPS);
    v4u* gp = (v4u*)(Z + (size_t)row * NAB + gcol + half * 64);
#pragma unroll
    for (int c = 0; c < 8; ++c) { const v4u g = gp[c]; v4u w;
        w.x = pk2(o[8 * c + 0] * r * bf_lo(g.x), o[8 * c + 1] * r * bf_hi(g.x)); w.y = pk2(o[8 * c + 2] * r * bf_lo(g.y), o[8 * c + 3] * r * bf_hi(g.y));
        w.z = pk2(o[8 * c + 4] * r * bf_lo(g.z), o[8 * c + 5] * r * bf_hi(g.z)); w.w = pk2(o[8 * c + 6] * r * bf_lo(g.w), o[8 * c + 7] * r * bf_hi(g.w)); gp[c] = w; }
}


using abf16 = attn_body::bf16;
__device__ __forceinline__ void attn_a_phase(Frame& F, bf16* Zu, char* shm) {
    abf16* Z = (abf16*)Zu;
    for (int idx = F.vcu; idx < 512; idx += F.G) {
        const int qb = idx & 15, g = (idx >> 4) & 3, kvh = (idx >> 6) & 1, seq = idx >> 7, h = kvh * 4 + g; const long rb = (long)seq * 4096;
        attn_body::attn_unit<8, 0, NAB>(Z + (rb + qb * 256) * NAB + ZA_Q + h * 64, Z + rb * NAB + ZA_K + kvh * 64, Z + rb * NAB + ZA_V + kvh * 64, Z + (rb + qb * 256) * NAB + ZA_G + h * 64, 64, shm, 0, 0.f);
    }
    for (int idx = F.vcu; idx < 512; idx += F.G) {
        const int qb = idx & 7, g = (idx >> 3) & 3, kvh = (idx >> 5) & 1, seq = idx >> 6, h = kvh * 4 + g; const long rb = (long)MP + (long)seq * 2048;
        attn_body::attn_unit<8, 0, NAB>(Z + (rb + qb * 256) * NAB + ZA_Q + h * 64, Z + rb * NAB + ZA_K + kvh * 64, Z + rb * NAB + ZA_V + kvh * 64, Z + (rb + qb * 256) * NAB + ZA_G + h * 64, 32, shm, 0, 0.f);
    }
}
__device__ __forceinline__ void attn_c_phase(Frame& F, bf16* Zu, char* shm, const float* sink, const float* rel_bias) {
    abf16* Z = (abf16*)Zu;
    LAS float* tab = (LAS float*)(F.lds + RING_OFF + attn_body::LDS_TAB);
    for (int grp = F.vcu; grp < 256; grp += F.G) {
        const int qbg = grp >> 1, kvh = grp & 1, row0 = qbg * 256;
        const int sbase = row0 < MP ? (row0 & ~4095) : (MP + ((row0 - MP) & ~2047)), slen = row0 < MP ? 4096 : 2048;
        const int p0 = row0 - sbase, k_lo = p0 - 128 < 0 ? 0 : p0 - 128, k_hi = p0 + 384 > slen ? slen : p0 + 384, NT = (k_hi - k_lo) >> 6;
        for (int g = 0; g < 8; ++g) {
            const int h = kvh * 8 + g;
            for (int i = F.tid; i < 768; i += NWAVES * 64) { const int rel = i - 383; tab[i] = (rel >= -128 && rel <= 128) ? rel_bias[t5_bucket(rel) * 16 + h] * LOG2E : -1e30f; }
            attn_body::attn_unit<8, 1, NCC>(Z + (long)row0 * NCC + ZC_Q + h * 64, Z + (long)(sbase + k_lo) * NCC + ZC_K + kvh * 64, Z + (long)(sbase + k_lo) * NCC + ZC_V + kvh * 64,
                                           Z + (long)row0 * NCC + ZC_G + h * 64, NT, shm, (k_lo - p0) + 383, sink[h] * LOG2E);
        }
    }
}
#ifndef MK_N_LAUNCHES
#define MK_N_LAUNCHES 1
#endif
constexpr int N_PHASES = 9;
struct Args { const float* in[12]; float* out; unsigned char* ws; int ph_lo, ph_hi; };
__global__ void __launch_bounds__(NWAVES * 64, 2) mk_fwd(Args args) {
    extern __shared__ __attribute__((aligned(16))) unsigned char lds[];
    Frame F;
    F.lds = (LAS unsigned char*)lds;
    F.MISC = (volatile LAS unsigned*)(F.lds + MISC_OFF);
    F.tid = threadIdx.x; F.lane = F.tid & 63; F.wave = __builtin_amdgcn_readfirstlane(F.tid >> 6);
    F.G = gridDim.x; { const int bx = blockIdx.x; F.vcu = (F.G % 8 == 0) ? (bx % 8) * (F.G / 8) + bx / 8 : bx; }
    unsigned char* ws = args.ws;
    unsigned* ctl = (unsigned*)(ws + WS_CTL);
    const float* x_prompt = args.in[0]; const float* x_sample = args.in[1]; const float* norm_g = args.in[2]; const float* w_in_ab = args.in[3];
    const float* qk_norm = args.in[4]; const float* ret_decay = args.in[5]; const float* w_out_ab = args.in[6]; const float* w_in_c = args.in[7];
    const float* sink_c = args.in[8]; const float* w_out_c = args.in[9]; const float* rel_bias = args.in[10]; const float* final_norm = args.in[11];
    float* out = args.out;
    bf16* XN0 = (bf16*)((unsigned char*)out + OUT_XN); bf16* WAB = (bf16*)((unsigned char*)out + OUT_WAB);
    bf16* WOAB = (bf16*)(ws + WS_WOAB); bf16* WC = (bf16*)(ws + WS_WC); bf16* WOC = (bf16*)(ws + WS_WOC);
    bf16* Z = (bf16*)(ws + WS_Z); bf16* X1B = (bf16*)(ws + WS_B);
    float* AXT = (float*)(ws + WS_AXT); float* LINT = (float*)(ws + WS_LINT); float* PART1 = (float*)(ws + WS_PART1); float* PART2 = (float*)(ws + WS_PART2);

    for (int u = F.tid; u < (LDS_BYTES - LDSCTL_OFF) / 4; u += NWAVES * 64) ((LAS unsigned*)(F.lds + LDSCTL_OFF))[u] = 0u;
    __syncthreads();
    const int lo = args.ph_lo, hi = args.ph_hi;
    XcdBarrier bar; bar.bar = ctl + CW_BAR; bar.x = 0; bar.st = nullptr;
    if (hi - lo > 1) bar = xcd_barrier_post(ctl + CW_BAR, F.MISC + 8);
#define IN(k) (lo <= (k) && (k) < hi)
#define SEAM(k) do { if (IN(k) && IN((k) + 1)) xcd_barrier(bar); } while (0)

    if (IN(0)) {
        LAS float* scr = (LAS float*)(F.lds + RING_OFF + F.wave * 16384);
        const int gw = F.vcu * NWAVES + F.wave, NGW = F.G * NWAVES;
        constexpr int I_AB = 16 * (NAB / 32), I_O = 16 * 32, I_C = 16 * (NCC / 32);
        constexpr int NITEMS = I_AB + I_O + I_C + I_O;
        for (int it = gw; it < NITEMS; it += NGW) {
            int r = it;
            if (r < I_AB) { p0_transpose_item(w_in_ab, DM, NAB, norm_g, true, WAB, scr, r, F.lane); continue; } r -= I_AB;
            if (r < I_O) { p0_transpose_item(w_out_ab, DM, DM, nullptr, false, WOAB, scr, r, F.lane); continue; } r -= I_O;
            if (r < I_C) { p0_transpose_item(w_in_c, DM, NCC, norm_g + DM, false, WC, scr, r, F.lane); continue; } r -= I_C;
            p0_transpose_item(w_out_c, DM, DM, nullptr, false, WOC, scr, r, F.lane);
        }
        for (int m = gw; m < MROWS; m += NGW) rms_row_to_bf16(F.lane, m < MP ? x_prompt + (size_t)m * DM : x_sample + (size_t)(m - MP) * DM, XN0 + (size_t)m * DM);
        const int gt = blockIdx.x * (NWAVES * 64) + F.tid, NGT = F.G * NWAVES * 64;
        for (int e = gt; e < 64 * 16 + 4096 * 32; e += NGT) {
            double ang; float* dst;
            if (e < 1024) { const int pos = e >> 4, j = e & 15; ang = (double)pos * pow(10000.0, -(double)j / 16.0); dst = AXT + 2 * e; }
            else { const int e2 = e - 1024, t = e2 >> 5, j = e2 & 31; ang = (double)t * pow(10000.0, -(double)j / 32.0); dst = LINT + 2 * e2; }
            dst[0] = (float)cos(ang); dst[1] = (float)sin(ang);
        }
    }
    SEAM(0);
    if (IN(1)) {
        pg8::Gemm g{XN0, WAB, MROWS, NAB, DM, DM}; pg8::StaticOrder S; S.init(MROWS, NAB, F.G, (int)blockIdx.x);
        EpiInAB E{Z, qk_norm, AXT, LINT};
        pg8::gemm_phase<EpiInAB, pg8::StaticOrder, true, true>(F.lds + RING_OFF, g, S, E);
    }
    SEAM(1);
    if (IN(2)) {
        attn_a_phase(F, Z, (char*)lds + RING_OFF);
        for (int it = blockIdx.x; it < 512; it += F.G) sc_ret_item(F, Z, it, ret_decay);
        __syncthreads();
    }
    SEAM(3);
    if (IN(4)) {
        pg8::Gemm g{Z + ZA_G, WOAB, MROWS, DM, DM, NAB}; pg8::StaticOrder S; S.init(MROWS, DM, F.G, (int)blockIdx.x);
        EpiOut E{x_prompt, x_sample, out, X1B, PART1};
        pg8::gemm_phase<EpiOut, pg8::StaticOrder, true, true>(F.lds + RING_OFF, g, S, E);
    }
    SEAM(4);
    if (IN(5)) {
        pg8::Gemm g{X1B, WC, MROWS, NCC, DM, DM}; pg8::StaticOrder S; S.init(MROWS, NCC, F.G, (int)blockIdx.x);
        EpiInC E{Z, PART1};
        pg8::gemm_phase<EpiInC, pg8::StaticOrder, true, true>(F.lds + RING_OFF, g, S, E);
    }
    SEAM(5);
    if (IN(6)) {
#ifdef SCALAR_C
        for (int it = blockIdx.x; it < 1024; it += F.G) sc_attn_item<1>(F, Z, it, sink_c, rel_bias);
        __syncthreads();
#else
        attn_c_phase(F, Z, (char*)lds + RING_OFF, sink_c, rel_bias);
#endif
    }
    SEAM(6);
    if (IN(7)) {
        pg8::Gemm g{Z + ZC_G, WOC, MROWS, DM, DM, NCC}; pg8::StaticOrder S; S.init(MROWS, DM, F.G, (int)blockIdx.x);
        EpiOut E{out, out + (size_t)MP * DM, out, nullptr, PART2};
        pg8::gemm_phase<EpiOut, pg8::StaticOrder, true, true>(F.lds + RING_OFF, g, S, E);
    }
    SEAM(7);
    if (IN(8)) {
        const int gw = F.vcu * NWAVES + F.wave, NGW = F.G * NWAVES;
        for (int m = gw; m < MROWS; m += NGW) {
            const f32x4* pp = (const f32x4*)(PART2 + (size_t)m * 16);
            const f32x4 p0 = pp[0], p1 = pp[1], p2 = pp[2], p3 = pp[3];
            const float s = ((p0.x + p0.y) + (p0.z + p0.w)) + ((p1.x + p1.y) + (p1.z + p1.w)) + ((p2.x + p2.y) + (p2.z + p2.w)) + ((p3.x + p3.y) + (p3.z + p3.w));
            const float rstd = rsqrtf(s * (1.f / DM) + EPS);
            f32x4* xr = (f32x4*)(out + (size_t)m * DM) + F.lane; const f32x4* gr = (const f32x4*)final_norm + F.lane;
#pragma unroll
            for (int j = 0; j < 4; ++j) xr[64 * j] = xr[64 * j] * rstd * gr[64 * j];
        }
    }
#undef IN
#undef SEAM
}

extern "C" void kernel_launch(void* const* d_in, const int* in_sizes, int n_in, void* d_out, int out_size, void* d_ws, size_t ws_size, hipStream_t stream) {
    static int grid = 0;
    if (grid == 0) {
        if (n_in != 12 || out_size != MROWS * DM || ws_size < WS_END) { fprintf(stderr, "kernel_launch: unexpected shapes (n_in %d, out %d, ws %zu)\n", n_in, out_size, ws_size); grid = -1; return; }
        int dev = 0, cus = 0, per_cu = 0;
        if (hipGetDevice(&dev) != hipSuccess || hipDeviceGetAttribute(&cus, hipDeviceAttributeMultiprocessorCount, dev) != hipSuccess) { grid = -1; return; }
        if (hipFuncSetAttribute((const void*)mk_fwd, hipFuncAttributeMaxDynamicSharedMemorySize, LDS_BYTES) != hipSuccess) { fprintf(stderr, "kernel_launch: hipFuncSetAttribute failed\n"); grid = -1; return; }
        if (hipOccupancyMaxActiveBlocksPerMultiprocessor(&per_cu, (const void*)mk_fwd, NWAVES * 64, LDS_BYTES) != hipSuccess || per_cu < 1) { fprintf(stderr, "kernel_launch: occupancy query says %d blocks per CU\n", per_cu); grid = -1; (void)hipGetLastError(); return; }
        grid = cus;
    }
    if (grid < 0) return;
    (void)hipMemsetAsync((char*)d_ws + WS_CTL, 0, CTL_ZERO_BYTES, stream);
    Args a{};
    for (int i = 0; i < 12; ++i) a.in[i] = (const float*)d_in[i];
    a.out = (float*)d_out; a.ws = (unsigned char*)d_ws;
#if MK_N_LAUNCHES == 1
    a.ph_lo = 0; a.ph_hi = N_PHASES;
    void* kargs[] = {&a};
    hipError_t e = hipLaunchCooperativeKernel((const void*)mk_fwd, dim3(grid), dim3(NWAVES * 64), kargs, LDS_BYTES, stream);
    if (e != hipSuccess) fprintf(stderr, "kernel_launch: cooperative launch failed: %s\n", hipGetErrorString(e));
#else
    for (int p = 0; p < N_PHASES; ++p) { if (p == 3) continue; a.ph_lo = p; a.ph_hi = p + 1; hipLaunchKernelGGL(mk_fwd, dim3(grid), dim3(NWAVES * 64), LDS_BYTES, stream, a); }
#endif
}
```

```cpp
#include <hip/hip_runtime.h>
#include <hip/hip_bf16.h>
#include <cstdio>
#include <cstdint>
#include <cmath>
namespace pg8 {
#define PG8_LAS __attribute__((address_space(3)))
typedef unsigned short bf16_t;
typedef short bf16x8 __attribute__((ext_vector_type(8)));
typedef float f32x4 __attribute__((ext_vector_type(4)));
typedef unsigned u32x4 __attribute__((ext_vector_type(4)));
constexpr int BM = 256, BK = 64, HALF = 128, HTB = HALF * BK * 2  , STAGE_BYTES = 8 * HTB, NXCD = 8, WGM = 8;

__host__ __device__ __forceinline__ int lds_byte(int r, int c) { const int st = (r >> 4) * 2 + (c >> 5), rr = r & 15, cc = c & 31, ob = rr * 64 + cc * 2; return st * 1024 + (ob ^ (((ob >> 9) & 1) << 5)); }
__host__ __device__ __forceinline__ void stage_rc(int b, int& R, int& C) { const int st = b / 1024, sb = b % 1024, swz = sb ^ (((sb >> 9) & 1) << 5); R = (st >> 1) * 16 + swz / 64; C = (st & 1) * 32 + (swz % 64) / 2; }
__host__ __device__ __forceinline__ int perm32(int rho) { const int n = rho >> 4, i = rho & 15; return 8 * (i >> 2) + 4 * n + (i & 3); }

struct Unit { int pm, pn; };
struct Gemm { const bf16_t* A; const bf16_t* Bt; int M, N, K, lda; };

struct StaticOrder {
    int nM, nN, nwg, G, c;
    __host__ __device__ void init(int M, int N, int G_, int c_) { nM = M / BM; nN = N / BM; nwg = nM * nN; G = G_; c = c_; }
    __host__ __device__ bool next(int i, Unit& u) const {
        const long L = (long)i * G + c; if (L >= nwg) return false;
        int wgid = (int)L; { const int q = nwg / NXCD, r = nwg % NXCD, xcd = wgid % NXCD, off = wgid / NXCD; wgid = (xcd < r ? xcd * (q + 1) : r * (q + 1) + (xcd - r) * q) + off; }
        const int nig = WGM * nN, gid = wgid / nig, fm = gid * WGM, gsz = (nM - fm) < WGM ? (nM - fm) : WGM;
        u.pm = fm + ((wgid % nig) % gsz); u.pn = (wgid % nig) / gsz; return true;
    }
    __device__ __forceinline__ void a_ready(const Unit&) const {}
    __device__ __forceinline__ void done(const Unit&) const {}
};

__device__ __forceinline__ unsigned cvt_pk_bf16(float lo, float hi) { unsigned r; asm volatile("v_cvt_pk_bf16_f32 %0, %1, %2" : "=v"(r) : "v"(lo), "v"(hi)); return r; }
template <class Epi, class Sched, bool ALIGN_EPI = false, bool SP2 = false>
__device__ __forceinline__ void gemm_phase(PG8_LAS unsigned char* lds, const Gemm g, const Sched& S, const Epi& E) {
    const int tid = threadIdx.x, wid = __builtin_amdgcn_readfirstlane(tid >> 6), lane = tid & 63, wr = wid >> 2, wc = wid & 3, fr = lane & 15, fq = lane >> 4;
    const int K = g.K, nt = K / BK;
    unsigned voffA[2], voffB[2];
#pragma unroll
    for (int i = 0; i < 2; ++i) { int R, C; stage_rc(tid * 16 + i * 8192, R, C); const int Rb = 64 * (R >> 5) + perm32(R & 31);
        voffA[i] = (unsigned)(R * g.lda + C) * 2u; voffB[i] = (unsigned)(Rb * K + C) * 2u; }
    const size_t kstep = (size_t)(BK * 2);
    const size_t hstepA = (size_t)HALF * g.lda * 2, tstepA = 2 * hstepA;
    const size_t hstepB = (size_t)32 * K * 2, tstepB = (size_t)BM * K * 2;
    const unsigned ldsw = (unsigned)wid * 1024u;
    const int aoff = lds_byte(wr * 64 + fr, fq * 8), boff = lds_byte(wc * 32 + fr, fq * 8);
#define PG8_SA(b, h) (((b) * 2 + (h)) * HTB)
#define PG8_SB(b, h) ((4 + (b) * 2 + (h)) * HTB)
#define PG8_STAGE(bufoff, gbase, voff) do { _Pragma("unroll") for (int _i = 0; _i < 2; ++_i) \
        __builtin_amdgcn_global_load_lds((const unsigned*)((const char*)(gbase) + (voff)[_i]), (PG8_LAS unsigned*)(lds + (bufoff) + ldsw + _i * 8192), 16, 0, 0); } while (0)
#define PG8_LDA(dst, b, h) do { _Pragma("unroll") for (int m = 0; m < 4; ++m) _Pragma("unroll") for (int k = 0; k < 2; ++k) dst[m][k] = *(const PG8_LAS bf16x8*)(lds + PG8_SA(b, h) + aoff + m * 2048 + k * 1024); } while (0)
#define PG8_LDB(dst, b, h) do { _Pragma("unroll") for (int n = 0; n < 2; ++n) _Pragma("unroll") for (int k = 0; k < 2; ++k) dst[n][k] = *(const PG8_LAS bf16x8*)(lds + PG8_SB(b, h) + boff + n * 2048 + k * 1024); } while (0)
#define PG8_MMA(ai, bj, At, Bt) do { __builtin_amdgcn_s_setprio(1); _Pragma("unroll") for (int m = 0; m < 4; ++m) _Pragma("unroll") for (int n = 0; n < 2; ++n) _Pragma("unroll") for (int k = 0; k < 2; ++k) \
        acc[ai][bj][m][n] = __builtin_amdgcn_mfma_f32_16x16x32_bf16(Bt[n][k], At[m][k], acc[ai][bj][m][n], 0, 0, 0); __builtin_amdgcn_s_setprio(0); } while (0)
#define PG8_WAIT_V(n) asm volatile("s_waitcnt vmcnt(" #n ")" ::: "memory")
#define PG8_WAIT_L(n) asm volatile("s_waitcnt lgkmcnt(" #n ")" ::: "memory")
#define PG8_BAR __builtin_amdgcn_s_barrier()
#define PG8_SCHED __builtin_amdgcn_sched_barrier(0)
    Unit cur, nxt; int ui = 0;
    if (!S.next(0, cur)) return;
    f32x4 acc[2][2][4][2];
#pragma unroll
    for (int a = 0; a < 2; ++a)
#pragma unroll
        for (int b = 0; b < 2; ++b)
#pragma unroll
            for (int m = 0; m < 4; ++m)
#pragma unroll
                for (int n = 0; n < 2; ++n) acc[a][b][m][n] = (f32x4){0.f, 0.f, 0.f, 0.f};
    bf16x8 At[4][2], B0[2][2], B1[2][2];
    const char* cA = (const char*)g.A + (size_t)cur.pm * tstepA; const char* cB = (const char*)g.Bt + (size_t)cur.pn * tstepB;
    S.a_ready(cur);
    if constexpr (SP2) {
        PG8_STAGE(PG8_SB(0, 0), cB, voffB); PG8_STAGE(PG8_SB(0, 1), cB + hstepB, voffB); PG8_STAGE(PG8_SA(0, 0), cA, voffA); PG8_STAGE(PG8_SA(0, 1), cA + hstepA, voffA);
        if (wr == 1) PG8_BAR;
        PG8_WAIT_V(2); PG8_BAR;
        PG8_STAGE(PG8_SB(1, 0), cB + kstep, voffB); PG8_STAGE(PG8_SA(1, 0), cA + kstep, voffA); PG8_STAGE(PG8_SB(1, 1), cB + hstepB + kstep, voffB);
        PG8_WAIT_V(6); PG8_BAR;
    } else {
        PG8_STAGE(PG8_SB(0, 0), cB, voffB); PG8_STAGE(PG8_SA(0, 0), cA, voffA); PG8_STAGE(PG8_SB(0, 1), cB + hstepB, voffB); PG8_STAGE(PG8_SA(0, 1), cA + hstepA, voffA);
        if (wr == 1) PG8_BAR;
        PG8_WAIT_V(4); PG8_BAR;
        PG8_STAGE(PG8_SB(1, 0), cB + kstep, voffB); PG8_STAGE(PG8_SA(1, 0), cA + kstep, voffA); PG8_STAGE(PG8_SB(1, 1), cB + hstepB + kstep, voffB);
        PG8_WAIT_V(6); PG8_BAR;
    }
    for (;;) {
        const bool has_next = S.next(ui + 1, nxt);
        const char* nA = has_next ? (const char*)g.A + (size_t)nxt.pm * tstepA : cA; const char* nB = has_next ? (const char*)g.Bt + (size_t)nxt.pn * tstepB : cB;
        for (int t = 0; t < nt; t += 2) {
            const bool last = (t == nt - 2);
            const char* a1 = cA + (size_t)(t + 1) * kstep;
            const char* a2 = last ? nA : cA + (size_t)(t + 2) * kstep; const char* b2 = last ? nB : cB + (size_t)(t + 2) * kstep;
            const char* a3 = a2 + kstep; const char* b3 = b2 + kstep;
            if (last && has_next) S.a_ready(nxt);
            if constexpr (SP2) {
            PG8_LDB(B0, 0, 0); PG8_LDB(B1, 0, 1); PG8_SCHED; PG8_LDA(At, 0, 0); PG8_STAGE(PG8_SA(1, 1), a1 + hstepA, voffA);
            PG8_WAIT_V(8); PG8_WAIT_L(0); PG8_BAR; PG8_MMA(0, 0, At, B0); PG8_MMA(0, 1, At, B1); PG8_BAR; PG8_SCHED;
            PG8_LDA(At, 0, 1); PG8_STAGE(PG8_SB(0, 0), b2, voffB); PG8_STAGE(PG8_SB(0, 1), b2 + hstepB, voffB); PG8_STAGE(PG8_SA(0, 0), a2, voffA);
            PG8_WAIT_V(8); PG8_WAIT_L(0); PG8_BAR; PG8_MMA(1, 0, At, B0); PG8_MMA(1, 1, At, B1); PG8_BAR; PG8_SCHED;
            PG8_LDB(B0, 1, 0); PG8_LDB(B1, 1, 1); PG8_SCHED; PG8_LDA(At, 1, 0); PG8_STAGE(PG8_SA(0, 1), a2 + hstepA, voffA);
            PG8_WAIT_V(8); PG8_WAIT_L(0); PG8_BAR; PG8_MMA(0, 0, At, B0); PG8_MMA(0, 1, At, B1); PG8_BAR; PG8_SCHED;
            PG8_LDA(At, 1, 1); PG8_STAGE(PG8_SB(1, 0), b3, voffB); PG8_STAGE(PG8_SB(1, 1), b3 + hstepB, voffB); PG8_STAGE(PG8_SA(1, 0), a3, voffA);
            PG8_WAIT_V(8); PG8_WAIT_L(0); PG8_BAR; PG8_MMA(1, 0, At, B0); PG8_MMA(1, 1, At, B1); PG8_BAR; PG8_SCHED;
            } else {
            PG8_LDB(B0, 0, 0); PG8_SCHED; PG8_LDA(At, 0, 0); PG8_STAGE(PG8_SA(1, 1), a1 + hstepA, voffA);
            PG8_WAIT_L(8); PG8_BAR; PG8_WAIT_L(0); PG8_MMA(0, 0, At, B0); PG8_BAR; PG8_SCHED;
            PG8_LDB(B1, 0, 1); PG8_STAGE(PG8_SB(0, 0), b2, voffB);
            PG8_BAR; PG8_WAIT_L(0); PG8_MMA(0, 1, At, B1); PG8_BAR;
            PG8_LDA(At, 0, 1); PG8_STAGE(PG8_SA(0, 0), a2, voffA);
            PG8_BAR; PG8_WAIT_L(0); PG8_MMA(1, 0, At, B0); PG8_BAR; PG8_SCHED;
            PG8_STAGE(PG8_SB(0, 1), b2 + hstepB, voffB);
            PG8_WAIT_V(6); PG8_BAR; PG8_MMA(1, 1, At, B1); PG8_BAR;
            PG8_LDB(B0, 1, 0); PG8_SCHED; PG8_LDA(At, 1, 0); PG8_STAGE(PG8_SA(0, 1), a2 + hstepA, voffA);
            PG8_WAIT_L(8); PG8_BAR; PG8_WAIT_L(0); PG8_MMA(0, 0, At, B0); PG8_BAR; PG8_SCHED;
            PG8_LDB(B1, 1, 1); PG8_STAGE(PG8_SB(1, 0), b3, voffB);
            PG8_BAR; PG8_WAIT_L(0); PG8_MMA(0, 1, At, B1); PG8_BAR;
            PG8_LDA(At, 1, 1); PG8_STAGE(PG8_SA(1, 0), a3, voffA);
            PG8_BAR; PG8_WAIT_L(0); PG8_MMA(1, 0, At, B0); PG8_BAR; PG8_SCHED;
            PG8_STAGE(PG8_SB(1, 1), b3 + hstepB, voffB);
            PG8_WAIT_V(6); PG8_BAR; PG8_MMA(1, 1, At, B1); PG8_BAR;
            }
        }
        if constexpr (ALIGN_EPI) { if (wr == 0) PG8_BAR; }
        if constexpr (!Epi::AFTER_DRAIN) { E(acc, cur, wr, wc, fr, fq); S.done(cur); }
        if (!has_next) break;
#pragma unroll
        for (int a = 0; a < 2; ++a)
#pragma unroll
            for (int b = 0; b < 2; ++b)
#pragma unroll
                for (int m = 0; m < 4; ++m)
#pragma unroll
                    for (int n = 0; n < 2; ++n) acc[a][b][m][n] = (f32x4){0.f, 0.f, 0.f, 0.f};
        cur = nxt; cA = nA; cB = nB; ++ui;
        if constexpr (ALIGN_EPI) { if (wr == 1) PG8_BAR; }
    }
    PG8_WAIT_V(0);
    if constexpr (!ALIGN_EPI) { if (wr == 0) PG8_BAR; }
    PG8_BAR;
    if constexpr (Epi::AFTER_DRAIN) { E.fused(acc, cur, wr, wc, fr, fq, lds, wid, lane); S.done(cur); }
#undef PG8_SA
#undef PG8_SB
#undef PG8_STAGE
#undef PG8_LDA
#undef PG8_LDB
#undef PG8_MMA
#undef PG8_WAIT_V
#undef PG8_WAIT_L
#undef PG8_BAR
#undef PG8_SCHED
}
}
namespace attn_body {
using bf16=__hip_bfloat16;
using bf16x8=__attribute__((ext_vector_type(8)))short;
using s16x4=__attribute__((ext_vector_type(4)))short;
using f32x16=__attribute__((ext_vector_type(16)))float;
using u32x4=__attribute__((ext_vector_type(4)))unsigned;
constexpr int D=64;
constexpr int NW=8,QBLK=32,QB=QBLK*NW,KVBLK=64;
constexpr int ATTN_UNIT_ROWS=QB;
__device__ __forceinline__ int crow(int r,int hi){return (r&3)+8*(r>>2)+4*hi;}
#define SBAR() __builtin_amdgcn_sched_barrier(0)
constexpr int NSLOT=3, SLOTB=8192;
constexpr int LDS_K=0, LDS_V=NSLOT*SLOTB, LDS_WS=2*NSLOT*SLOTB, LDS_OST=LDS_WS+NW*64*4, LDS_TAB=LDS_OST+NW*4096, LDS_BYTES=LDS_TAB+3072;
constexpr float C2=0.125f*1.4426950408889634f;
__device__ __forceinline__ void glds16(const void*gsrc,unsigned lds_dst){unsigned keep;
  asm volatile("s_mov_b32 %0, m0\n\ts_mov_b32 m0, %2\n\ts_nop 0\n\tglobal_load_lds_dwordx4 %1, off\n\ts_mov_b32 m0, %0":"=&s"(keep):"v"(gsrc),"s"(lds_dst):"memory");}
__device__ __forceinline__ float max3f(float a,float b,float c){float r;asm("v_max3_f32 %0, %1, %2, %3":"=v"(r):"v"(a),"v"(b),"v"(c));return r;}
__device__ __forceinline__ float max2f(float a,float b){float r;asm("v_max_f32_e32 %0, %1, %2":"=v"(r):"v"(a),"v"(b));return r;}
__device__ __forceinline__ float fadd_s(float a,float b){float r;asm("v_add_f32_e32 %0, %1, %2":"=v"(r):"v"(a),"v"(b));return r;}
__device__ __forceinline__ float fsub_s(float a,float b){float r;asm("v_sub_f32_e32 %0, %1, %2":"=v"(r):"v"(a),"v"(b));return r;}
typedef float f32x2_t __attribute__((ext_vector_type(2))); typedef __bf16 bf16x2_t __attribute__((ext_vector_type(2)));
__device__ __forceinline__ unsigned cvtpk_s(float lo,float hi){f32x2_t v={lo,hi};bf16x2_t b=__builtin_convertvector(v,bf16x2_t);return __builtin_bit_cast(unsigned,b);}
#define WAIT_BAR(N) asm volatile("s_waitcnt vmcnt(" #N ") lgkmcnt(0)\n\ts_barrier":::"memory")

__device__ __forceinline__ void qkt(f32x16&p0,f32x16&p1,const char*Kslot,const bf16x8*qr,const f32x16&negm,int r32,int hi){
  const char*kb=Kslot+hi*1024+r32*16;
  #pragma unroll
  for(int d0=0;d0<4;++d0){
    const bf16x8 b0=*reinterpret_cast<const bf16x8*>(kb+d0*2048);
    const bf16x8 b1=*reinterpret_cast<const bf16x8*>(kb+d0*2048+512);
    if(d0==0){p0=__builtin_amdgcn_mfma_f32_32x32x16_bf16(b0,qr[0],negm,0,0,0);p1=__builtin_amdgcn_mfma_f32_32x32x16_bf16(b1,qr[0],negm,0,0,0);}
    else{p0=__builtin_amdgcn_mfma_f32_32x32x16_bf16(b0,qr[d0],p0,0,0,0);p1=__builtin_amdgcn_mfma_f32_32x32x16_bf16(b1,qr[d0],p1,0,0,0);}}
}
typedef __attribute__((address_space(3))) const char* lds_cptr;
typedef short v4i16_t __attribute__((ext_vector_type(4)));
__device__ __forceinline__ void kload8(bf16x8*kf,lds_cptr kp){
  kf[0]=*(const __attribute__((address_space(3))) bf16x8*)(kp);      kf[1]=*(const __attribute__((address_space(3))) bf16x8*)(kp+512);
  kf[2]=*(const __attribute__((address_space(3))) bf16x8*)(kp+2048); kf[3]=*(const __attribute__((address_space(3))) bf16x8*)(kp+2560);
  kf[4]=*(const __attribute__((address_space(3))) bf16x8*)(kp+4096); kf[5]=*(const __attribute__((address_space(3))) bf16x8*)(kp+4608);
  kf[6]=*(const __attribute__((address_space(3))) bf16x8*)(kp+6144); kf[7]=*(const __attribute__((address_space(3))) bf16x8*)(kp+6656);
}
__device__ __forceinline__ void kload2(bf16x8*kf,lds_cptr kp,int j){ kf[2*j]=*(const __attribute__((address_space(3))) bf16x8*)(kp+j*2048); kf[2*j+1]=*(const __attribute__((address_space(3))) bf16x8*)(kp+j*2048+512); }
__device__ __forceinline__ s16x4 vtr(lds_cptr p){ return __builtin_bit_cast(s16x4,__builtin_amdgcn_ds_read_tr16_b64_v4i16((__attribute__((address_space(3))) v4i16_t*)p)); }
__device__ __forceinline__ float rowmax(const f32x16&p0,const f32x16&p1){
  float a=max3f(p0[0],p0[1],p1[0]),b=max3f(p0[2],p0[3],p1[1]);a=max3f(a,p1[2],p1[3]);
  #pragma unroll
  for(int r=4;r<16;r+=4){a=max3f(a,p0[r],p0[r+1]);b=max3f(b,p0[r+2],p0[r+3]);a=max3f(a,p1[r],p1[r+1]);b=max3f(b,p1[r+2],p1[r+3]);}
  const float m=max2f(a,b);
  auto rr=__builtin_amdgcn_permlane32_swap(__float_as_uint(m),__float_as_uint(m),false,false);
  return max2f(__uint_as_float(rr[0]),__uint_as_float(rr[1]));
}
__device__ __forceinline__ void pv(f32x16*o,int vb,bf16x8 pa0,bf16x8 pa1,bf16x8 pa2,bf16x8 pa3){
  #pragma unroll
  for(int d0=0;d0<2;++d0){s16x4 lo[4],hi[4];
    #pragma unroll
    for(int ks=0;ks<4;++ks){
      asm volatile("ds_read_b64_tr_b16 %0,%1 offset:%c2":"=&v"(lo[ks]):"v"(vb),"i"(d0*4096+ks*1024):"memory");
      asm volatile("ds_read_b64_tr_b16 %0,%1 offset:%c2":"=&v"(hi[ks]):"v"(vb),"i"(d0*4096+ks*1024+512):"memory");}
    asm volatile("s_waitcnt lgkmcnt(0)":::"memory");SBAR();
    #define PK(k) (bf16x8){lo[k][0],lo[k][1],lo[k][2],lo[k][3],hi[k][0],hi[k][1],hi[k][2],hi[k][3]}
    o[d0]=__builtin_amdgcn_mfma_f32_32x32x16_bf16(pa0,PK(0),o[d0],0,0,0);
    o[d0]=__builtin_amdgcn_mfma_f32_32x32x16_bf16(pa1,PK(1),o[d0],0,0,0);
    o[d0]=__builtin_amdgcn_mfma_f32_32x32x16_bf16(pa2,PK(2),o[d0],0,0,0);
    o[d0]=__builtin_amdgcn_mfma_f32_32x32x16_bf16(pa3,PK(3),o[d0],0,0,0);
    #undef PK
  }
}

#ifndef ATTN_STORE16
#define ATTN_STORE16(p,v) (*(u32x4*)(p)=(v))
#endif
template<int THRL,int MODE,int LD> __device__ __forceinline__ void attn_unit(const bf16*Qw0,const bf16*__restrict__ Kh,const bf16*__restrict__ Vh,bf16*Gw0,const int NT,char*shm,const int relb0,const float sink2){
  const int tid=threadIdx.x,lane=tid&63,r32=lane&31,hi=lane>>5; const int wid=__builtin_amdgcn_readfirstlane(tid>>6);
  const bf16*Qw=Qw0+(long)(wid*QBLK)*LD;
  const unsigned lds0=(unsigned)(uintptr_t)shm;
  float*wsf=(float*)(shm+LDS_WS)+wid*64;
  const bf16*ksrc=Kh+(long)lane*LD+wid*8;
  const bf16*vsrc=Vh+(long)(16*(wid&3)+(lane>>2))*LD+(wid>>2)*32+(lane&3)*8;
  const unsigned kdst=lds0+LDS_K+wid*1024, vdst=lds0+LDS_V+wid*1024;
  #define DMA_K(t,slot) glds16(ksrc+(long)(t)*KVBLK*LD,(unsigned)__builtin_amdgcn_readfirstlane(kdst+(slot)))
  #define DMA_V(t,slot) glds16(vsrc+(long)(t)*KVBLK*LD,(unsigned)__builtin_amdgcn_readfirstlane(vdst+(slot)))
  const int vb0=(int)(lds0+LDS_V)+((lane>>4)&1)*32+(lane&3)*8+(4*hi+((lane&15)>>2))*64;
  const char*Kbase=shm+LDS_K; bf16x8 kf[8];
  const lds_cptr shm3=(lds_cptr)shm; const lds_cptr kp0=shm3+LDS_K+hi*1024+r32*16; const lds_cptr vp0=shm3+LDS_V+((lane>>4)&1)*32+(lane&3)*8+(4*hi+((lane&15)>>2))*64;
  DMA_K(0,0);DMA_V(0,0);DMA_K(1,SLOTB);
  bf16x8 qr[4];
  #pragma unroll
  for(int d0=0;d0<4;++d0)qr[d0]=*reinterpret_cast<const bf16x8*>(&Qw[(long)r32*LD+d0*16+hi*8]);
  float mhat=(MODE==1)?sink2:0.f,l_reg=(MODE==1&&hi==0)?1.f:0.f;f32x16 o[2];o[0]=f32x16{};o[1]=f32x16{};f32x16 negm;
  _Pragma("unroll") for(int r=0;r<16;++r)negm[r]=-mhat; asm volatile("":"+v"(negm));
  const __attribute__((address_space(3))) float* tabl=(const __attribute__((address_space(3))) float*)((lds_cptr)shm+LDS_TAB)+(relb0-wid*QBLK-r32+4*hi);
  #define CMASK(P0,P1,t) do{ if(MODE==1){ const __attribute__((address_space(3))) float* tp_=tabl+64*(t); \
      _Pragma("unroll") for(int r=0;r<16;++r){P0[r]+=tp_[(r&3)+8*(r>>2)];P1[r]+=tp_[32+(r&3)+8*(r>>2)];} } }while(0)
  bool resc=false;
  #define START(P0,P1) do{ const float rm=rowmax(P0,P1); resc=false; \
    { const float dl=(MODE==1)?__builtin_fmaxf(rm,0.f):rm; mhat=fadd_s(mhat,dl); if(MODE==1)l_reg*=__builtin_amdgcn_exp2f(-dl); \
      _Pragma("unroll") for(int r=0;r<16;++r){P0[r]=fsub_s(P0[r],dl);P1[r]=fsub_s(P1[r],dl);} \
      _Pragma("unroll") for(int r=0;r<16;++r)negm[r]=-mhat; asm volatile("":"+v"(negm)); } \
    _Pragma("unroll") for(int r=0;r<16;++r)P0[r]=__builtin_amdgcn_exp2f(P0[r]); }while(0)
  #define RESC() do{ if(resc){ asm volatile("s_waitcnt lgkmcnt(0)":::"memory"); \
      _Pragma("unroll") for(int d_=0;d_<2;++d_) _Pragma("unroll") for(int r=0;r<16;++r)o[d_][r]*=wsf[crow(r,hi)]; } }while(0)
  f32x16 pA0,pA1,pB0,pB1;
  int sl_prev=0,sl_cur=0,sl_next=SLOTB;
  #define ROT() do{sl_prev=sl_cur;sl_cur=sl_next;sl_next=(sl_next==(NSLOT-1)*SLOTB)?0:sl_next+SLOTB;}while(0)
  DMA_K(2,2*SLOTB);
  WAIT_BAR(3);
  qkt(pA0,pA1,Kbase,qr,negm,r32,hi);asm volatile("s_nop 15\n\ts_nop 7":"+v"(pA0),"+v"(pA1));CMASK(pA0,pA1,0);
  START(pA0,pA1);
  _Pragma("unroll") for(int r=0;r<16;++r)pA1[r]=__builtin_amdgcn_exp2f(pA1[r]);
  WAIT_BAR(0);
  DMA_K(3,0);DMA_V(1,SLOTB);
  ROT();
  kload8(kf,kp0+sl_cur);
  WAIT_BAR(2);
  s16x4 vlo[8],vhi[8]; u32x4 pw0,pw1,pw2,pw3;
  #define PKW(P,B) cvtpk_s(P[B],P[B+1])
  #define PAF(k) __builtin_bit_cast(bf16x8,pw##k)
  #define VFR(i) (bf16x8){vlo[i][0],vlo[i][1],vlo[i][2],vlo[i][3],vhi[i][0],vhi[i][1],vhi[i][2],vhi[i][3]}
  #define PIN(x) asm volatile("":"+v"(x))
  #define MX3(a,b,c) __builtin_fmaxf(__builtin_fmaxf((a),(b)),(c))
  #define GAPA(MF,A0,A1,A2,A3,W0,W1,PW) do{ MF; sacc+=A0; sacc+=A1; sacc+=A2; sacc+=A3; PIN(sacc); W0; W1; PIN(PW); SBAR(); }while(0)
  #define EX(v) __builtin_amdgcn_exp2f(v)
  #define GAPB(MF,X,B) do{ MF; X[B]=EX(X[B]); X[B+1]=EX(X[B+1]); X[B+2]=EX(X[B+2]); X[B+3]=EX(X[B+3]); PIN(X); SBAR(); }while(0)
  #define VRD(i) do{ vlo[i]=vtr(vp_+(((i)>>2)*4096+((i)&3)*1024)); vhi[i]=vtr(vp_+(((i)>>2)*4096+((i)&3)*1024+512)); }while(0)
  #define KRD(G,j) do{ if(G){ kload2(kf,kp0+sl_next,j); SBAR(); } }while(0)
  #define STEP(C0,C1,P0,P1,t,GK,GV,GL) do{ SBAR(); \
    const lds_cptr vp_=vp0+sl_prev; \
    VRD(0); SBAR(); float sacc=(P0[0]+P0[1]); \
    GAPA(C0=__builtin_amdgcn_mfma_f32_32x32x16_bf16(kf[0],qr[0],negm,0,0,0), P0[2],P0[3],P0[4],P0[5],     pw0[0]=PKW(P0,0), pw0[1]=PKW(P0,2), pw0); \
    VRD(4); SBAR(); GAPA(C1=__builtin_amdgcn_mfma_f32_32x32x16_bf16(kf[1],qr[0],negm,0,0,0), P0[6],P0[7],P0[8],P0[9],     pw0[2]=PKW(P0,4), pw0[3]=PKW(P0,6), pw0); \
    VRD(1); SBAR(); GAPA(C0=__builtin_amdgcn_mfma_f32_32x32x16_bf16(kf[2],qr[1],C0,0,0,0),   P0[10],P0[11],P0[12],P0[13], pw1[0]=PKW(P0,8), pw1[1]=PKW(P0,10), pw1); \
    VRD(5); SBAR(); GAPA(C1=__builtin_amdgcn_mfma_f32_32x32x16_bf16(kf[3],qr[1],C1,0,0,0),   P0[14],P0[15],P1[0],P1[1],   pw1[2]=PKW(P0,12),pw1[3]=PKW(P0,14), pw1); \
    VRD(2); SBAR(); GAPA(C0=__builtin_amdgcn_mfma_f32_32x32x16_bf16(kf[4],qr[2],C0,0,0,0),   P1[2],P1[3],P1[4],P1[5],     pw2[0]=PKW(P1,0), pw2[1]=PKW(P1,2), pw2); \
    VRD(6); SBAR(); GAPA(C1=__builtin_amdgcn_mfma_f32_32x32x16_bf16(kf[5],qr[2],C1,0,0,0),   P1[6],P1[7],P1[8],P1[9],     pw2[2]=PKW(P1,4), pw2[3]=PKW(P1,6), pw2); \
    VRD(3); SBAR(); GAPA(C0=__builtin_amdgcn_mfma_f32_32x32x16_bf16(kf[6],qr[3],C0,0,0,0),   P1[10],P1[11],P1[12],P1[13], pw3[0]=PKW(P1,8), pw3[1]=PKW(P1,10), pw3); \
    VRD(7); SBAR(); GAPA(C1=__builtin_amdgcn_mfma_f32_32x32x16_bf16(kf[7],qr[3],C1,0,0,0),   P1[14],P1[15],0.f,0.f,       pw3[2]=PKW(P1,12),pw3[3]=PKW(P1,14), pw3); \
    l_reg+=sacc; \
    if(GK){DMA_K((t)+3,sl_cur);} if(GV){DMA_V((t)+1,sl_next);} \
    CMASK(C0,C1,t); \
    { float a=MX3(C0[0],C0[1],C1[0]),b=MX3(C0[2],C0[3],C1[1]); a=MX3(a,C1[2],C1[3]); \
      _Pragma("unroll") for(int r=4;r<16;r+=4){a=MX3(a,C0[r],C0[r+1]);b=MX3(b,C0[r+2],C0[r+3]);a=MX3(a,C1[r],C1[r+1]);b=MX3(b,C1[r+2],C1[r+3]);} \
      float rm=__builtin_fmaxf(a,b); { auto rr=__builtin_amdgcn_permlane32_swap(__float_as_uint(rm),__float_as_uint(rm),false,false); rm=__builtin_fmaxf(__uint_as_float(rr[0]),__uint_as_float(rr[1])); } \
      resc=false; \
      if(__builtin_expect(__any(rm>(float)THRL),0)){ const float dl=__builtin_fmaxf(rm,0.f); mhat+=dl; \
        _Pragma("unroll") for(int r=0;r<16;++r){C0[r]-=dl;C1[r]-=dl;} \
        _Pragma("unroll") for(int r=0;r<16;++r)negm[r]=-mhat; asm volatile("":"+v"(negm)); \
        const float f=__builtin_amdgcn_exp2f(-dl); l_reg*=f; if(hi==0)wsf[r32]=f; resc=true; } } \
    SBAR(); \
    GAPB(o[0]=__builtin_amdgcn_mfma_f32_32x32x16_bf16(PAF(0),VFR(0),o[0],0,0,0), C0,0); \
    GAPB(o[1]=__builtin_amdgcn_mfma_f32_32x32x16_bf16(PAF(0),VFR(4),o[1],0,0,0), C0,4); \
    KRD(GL,0); GAPB(o[0]=__builtin_amdgcn_mfma_f32_32x32x16_bf16(PAF(1),VFR(1),o[0],0,0,0), C0,8); \
    KRD(GL,1); GAPB(o[1]=__builtin_amdgcn_mfma_f32_32x32x16_bf16(PAF(1),VFR(5),o[1],0,0,0), C0,12); \
    KRD(GL,2); GAPB(o[0]=__builtin_amdgcn_mfma_f32_32x32x16_bf16(PAF(2),VFR(2),o[0],0,0,0), C1,0); \
    KRD(GL,3); GAPB(o[1]=__builtin_amdgcn_mfma_f32_32x32x16_bf16(PAF(2),VFR(6),o[1],0,0,0), C1,4); \
    GAPB(o[0]=__builtin_amdgcn_mfma_f32_32x32x16_bf16(PAF(3),VFR(3),o[0],0,0,0), C1,8); \
    GAPB(o[1]=__builtin_amdgcn_mfma_f32_32x32x16_bf16(PAF(3),VFR(7),o[1],0,0,0), C1,12); \
    }while(0)
  int t=1;
  for(;t+5<NT;t+=2){
    STEP(pB0,pB1,pA0,pA1,t,true,true,true);     WAIT_BAR(2); RESC(); ROT();
    STEP(pA0,pA1,pB0,pB1,t+1,true,true,true);   WAIT_BAR(2); RESC(); ROT();
  }
  #define ENDW(tt) do{ if((tt)+3<NT){WAIT_BAR(2);} else if((tt)+2<NT){WAIT_BAR(1);} else {WAIT_BAR(0);} }while(0)
  for(;t+1<NT;t+=2){
    STEP(pB0,pB1,pA0,pA1,t,(t+3<NT),(t+1<NT),(t+1<NT));       ENDW(t);   RESC(); ROT();
    STEP(pA0,pA1,pB0,pB1,t+1,(t+4<NT),(t+2<NT),(t+2<NT));     ENDW(t+1); RESC(); ROT();
  }
  STEP(pB0,pB1,pA0,pA1,NT-1,false,false,false); RESC();
  { float sacc=pB0[0]+pB0[1]; _Pragma("unroll") for(int r=2;r<16;++r)sacc+=pB0[r]; _Pragma("unroll") for(int r=0;r<16;++r)sacc+=pB1[r]; l_reg+=sacc;
    pw0=(u32x4){PKW(pB0,0),PKW(pB0,2),PKW(pB0,4),PKW(pB0,6)};pw1=(u32x4){PKW(pB0,8),PKW(pB0,10),PKW(pB0,12),PKW(pB0,14)};pw2=(u32x4){PKW(pB1,0),PKW(pB1,2),PKW(pB1,4),PKW(pB1,6)};pw3=(u32x4){PKW(pB1,8),PKW(pB1,10),PKW(pB1,12),PKW(pB1,14)};
    SBAR(); pv(o,vb0+sl_cur,PAF(0),PAF(1),PAF(2),PAF(3)); }
  #undef PKW
  #undef PAF
  #undef VFR
  #undef PIN
  #undef MX3
  #undef GAPA
  #undef GAPB
  #undef EX
  #undef VRD
  #undef KRD
  #undef STEP
  #undef ENDW
  {auto rr=__builtin_amdgcn_permlane32_swap(__float_as_uint(l_reg),__float_as_uint(l_reg),false,false);l_reg=__uint_as_float(rr[0])+__uint_as_float(rr[1]);}
  if(hi==0)wsf[32+r32]=l_reg;asm volatile("s_waitcnt lgkmcnt(0)":::"memory");
  float rli[16];
  #pragma unroll
  for(int r=0;r<16;++r)rli[r]=__builtin_amdgcn_rcpf(wsf[32+crow(r,hi)]);
  bf16*Ow=Gw0+(long)(wid*QBLK)*LD;
  { bf16*stg=(bf16*)(shm+LDS_OST)+wid*2048;
    #pragma unroll
    for(int r=0;r<16;++r){const int orow=crow(r,hi);
      #pragma unroll
      for(int d0=0;d0<2;++d0)stg[orow*64+d0*32+r32]=__float2bfloat16(o[d0][r]*rli[r]);}
    asm volatile("s_waitcnt lgkmcnt(0)":::"memory");
    #pragma unroll
    for(int i=0;i<4;++i){const int row=i*8+(lane>>3),ch=lane&7; const u32x4 v=*(const u32x4*)(stg+row*64+ch*8); const u32x4 g=*(const u32x4*)(Ow+(long)row*LD+ch*8); u32x4 w;
      _Pragma("unroll") for(int e=0;e<4;++e){ w[e]=cvtpk_s(__builtin_bit_cast(float,v[e]<<16)*__builtin_bit_cast(float,g[e]<<16), __builtin_bit_cast(float,v[e]&0xffff0000u)*__builtin_bit_cast(float,g[e]&0xffff0000u)); }
      ATTN_STORE16(Ow+(long)row*LD+ch*8,w);} }
  asm volatile("s_waitcnt lgkmcnt(0)\n\ts_barrier":::"memory");
  #undef DMA_K
  #undef DMA_V
  #undef CMASK
  #undef START
  #undef RESC
  #undef ROT
}
constexpr int ATTN_LDS_BYTES=LDS_BYTES;
#undef SBAR
#undef WAIT_BAR
}

constexpr int NWAVES = 8;
constexpr int DM = 1024, MROWS = 32768, MP = 16384;
constexpr int NAB = 2816, NCC = 2304;
constexpr float EPS = 1e-6f, LOG2E = 1.4426950408889634f, QSCALE = 0.125f * 1.4426950408889634f;
constexpr int ZA_Q = 0, ZA_K = 512, ZA_V = 640, ZB_Q = 768, ZB_K = 1024, ZB_V = 1280, ZA_G = 1792, ZB_G = 2304;
constexpr int ZC_Q = 0, ZC_K = 1024, ZC_V = 1152, ZC_G = 1280;

constexpr size_t MiB = 1u << 20;
constexpr size_t WS_CTL = 0, CTL_ZERO_BYTES = 64 * 1024;
constexpr size_t WS_AXT = 1 * MiB;
constexpr size_t WS_LINT = 1 * MiB + 65536;
constexpr size_t WS_PART1 = 3 * MiB, WS_PART2 = 5 * MiB;
constexpr size_t WS_WOAB = 7 * MiB, WS_WC = 9 * MiB, WS_WOC = 14 * MiB;
constexpr size_t WS_Z = 16 * MiB;
constexpr size_t WS_B = 192 * MiB;
constexpr size_t WS_END = 256 * MiB;
constexpr size_t OUT_XN = 0, OUT_WAB = 64 * MiB;

constexpr int CW_BAR = 1024;

constexpr int RING_OFF = 0, RING_BYTES = 131072;
constexpr int LDSCTL_OFF = RING_BYTES, MISC_OFF = LDSCTL_OFF + 320;
constexpr int LDS_BYTES = 147456;

#define GAS __attribute__((address_space(1)))
#define LAS __attribute__((address_space(3)))
typedef unsigned short bf16;
typedef unsigned v4u __attribute__((ext_vector_type(4)));
typedef float f32x4 __attribute__((ext_vector_type(4)));
typedef float f32x2 __attribute__((ext_vector_type(2)));
#define LDS_WAIT() asm volatile("s_waitcnt lgkmcnt(0)" ::: "memory")
#define VM_WAIT() asm volatile("s_waitcnt vmcnt(0)" ::: "memory")
__device__ __forceinline__ unsigned f2bf(float f) { unsigned u = __builtin_bit_cast(unsigned, f); return (u + 0x7fffu + ((u >> 16) & 1u)) >> 16; }
__device__ __forceinline__ unsigned pk2(float lo, float hi) { return f2bf(lo) | (f2bf(hi) << 16); }
__device__ __forceinline__ float bf_lo(unsigned w) { return __builtin_bit_cast(float, w << 16); }
__device__ __forceinline__ float bf_hi(unsigned w) { return __builtin_bit_cast(float, w & 0xffff0000u); }
__device__ __forceinline__ int seq_pos(int row) { return row < MP ? (row & 4095) : (row & 2047); }
__device__ __forceinline__ float silu_f(float v) { return v * __builtin_amdgcn_rcpf(1.f + __builtin_amdgcn_exp2f(-v * LOG2E)); }

#define XB_TMO      128
#define XB_XCNT(j)  (256  + 64 * (j))
#define XB_XSUB(j)  (1280 + 64 * (j))
#define XB_XGEN(j)  (2304 + 64 * (j))
#define XB_TOP      3328
#define XB_TOPGEN   3392
#define XCD_BAR_WORDS 3456
#define XB_SPIN_CAP (1u << 18)
__device__ __forceinline__ unsigned xb_ld(unsigned* p)              { return __hip_atomic_load(p, __ATOMIC_RELAXED, __HIP_MEMORY_SCOPE_AGENT); }
__device__ __forceinline__ unsigned xb_add(unsigned* p, unsigned v) { return __hip_atomic_fetch_add(p, v, __ATOMIC_RELAXED, __HIP_MEMORY_SCOPE_AGENT); }
__device__ __forceinline__ unsigned xb_xcc_id() { return (unsigned)__builtin_amdgcn_s_getreg((3 << 11) | 20) & 0xFu; }
#define XB_SPIN(cond, bar) do { unsigned _sp = 0; while (cond) { __builtin_amdgcn_s_sleep(1); \
    if ((++_sp & 255u) == 0u) { if (xb_ld(&(bar)[XB_TMO])) break; if (_sp > XB_SPIN_CAP) { atomicAdd(&(bar)[XB_TMO], 1u); break; } } } } while (0)
struct XcdBarrier { unsigned* bar; unsigned x; volatile LAS unsigned* st; };
__device__ __forceinline__ XcdBarrier xcd_barrier_post(unsigned* bar, volatile LAS unsigned* st) {
    XcdBarrier b; b.bar = bar; b.x = xb_xcc_id(); b.st = st;
    if (threadIdx.x == 0) (void)xb_add(&bar[XB_XCNT(b.x)], 1u);
    return b;
}
__device__ __forceinline__ void xcd_barrier_complete(unsigned* bar, unsigned x, unsigned& nloc, unsigned& nx) {
    const unsigned G = gridDim.x * gridDim.y * gridDim.z;
    unsigned sum, cnt, mine, sp = 0u;
    for (;;) {
        sum = 0u; cnt = 0u; mine = 0u;
#pragma unroll
        for (unsigned j = 0; j < 16; ++j) { const unsigned c = xb_ld(&bar[XB_XCNT(j)]); sum += c; cnt += (c > 0u) ? 1u : 0u; mine = (j == x) ? c : mine; }
        if (sum == G) break;
        __builtin_amdgcn_s_sleep(1);
        if ((++sp & 255u) == 0u) { if (xb_ld(&bar[XB_TMO])) break; if (sp > XB_SPIN_CAP) { atomicAdd(&bar[XB_TMO], 1u); break; } }
    }
    nloc = mine > 0u ? mine : 1u; nx = cnt > 0u ? cnt : 1u;
}
__device__ __forceinline__ void xcd_barrier(const XcdBarrier& b) {
    asm volatile("s_waitcnt vmcnt(0)" ::: "memory");
    __syncthreads();
    if (threadIdx.x == 0) {
        unsigned* bar = b.bar;
        __builtin_amdgcn_s_waitcnt(0);
        unsigned nloc = b.st[0], nx = b.st[1];
        if (nloc == 0u) { xcd_barrier_complete(bar, b.x, nloc, nx); b.st[0] = nloc; b.st[1] = nx; }
        const unsigned old = xb_add(&bar[XB_XSUB(b.x)], 1u);
        const unsigned gen = old / nloc;
        if (old + 1u == (gen + 1u) * nloc) {
            __builtin_amdgcn_fence(__ATOMIC_RELEASE, "agent");
            asm volatile("s_waitcnt vmcnt(0)" ::: "memory");
            const unsigned og = xb_add(&bar[XB_TOP], 1u);
            const unsigned tg = og / nx;
            if (og + 1u == (tg + 1u) * nx) xb_add(&bar[XB_TOPGEN], 1u);
            else XB_SPIN(xb_ld(&bar[XB_TOPGEN]) == tg, bar);
            __builtin_amdgcn_fence(__ATOMIC_ACQUIRE, "agent");
            xb_add(&bar[XB_XGEN(b.x)], 1u);
            asm volatile("s_waitcnt vmcnt(0)" ::: "memory");
        } else {
            XB_SPIN(xb_ld(&bar[XB_XGEN(b.x)]) == gen, bar);
            __builtin_amdgcn_fence(__ATOMIC_ACQUIRE, "agent");
            asm volatile("s_waitcnt vmcnt(0)" ::: "memory");
        }
    }
    __syncthreads();
}

using pg8::Unit; using pg8::cvt_pk_bf16;
__device__ __forceinline__ f32x4 rot4(f32x4 y, f32x4 cs) { return (f32x4){y.x * cs.x - y.y * cs.y, y.x * cs.y + y.y * cs.x, y.z * cs.z - y.w * cs.w, y.z * cs.w + y.w * cs.z}; }
__device__ __forceinline__ f32x4 silu4(f32x4 v) { return (f32x4){silu_f(v.x), silu_f(v.y), silu_f(v.z), silu_f(v.w)}; }
__device__ __forceinline__ v4u pack8(f32x4 a, f32x4 b) { v4u w; w.x = cvt_pk_bf16(a.x, a.y); w.y = cvt_pk_bf16(a.z, a.w); w.z = cvt_pk_bf16(b.x, b.y); w.w = cvt_pk_bf16(b.z, b.w); return w; }

struct EpiInAB {
    static constexpr bool AFTER_DRAIN = false;
    bf16* Z; const float* gain; const float* axtab; const float* lintab;
    __device__ __forceinline__ void operator()(const f32x4 (&acc)[2][2][4][2], const Unit& u, int wr, int wc, int fr, int fq) const {
        const int pn = u.pn;
        int kind;
        if (pn < 2) kind = 1; else if (pn == 2) kind = (wc < 2) ? 2 : 0; else if (pn == 3) kind = 3; else if (pn == 4) kind = 4; else if (pn < 7) kind = 0; else kind = 5;
        const int colw = pn * 256 + wc * 64 + fq * 8;
        f32x4 gv[2][2];
        if (kind == 1 || kind == 2) {
            const float* gp = gain + (kind == 2 ? 64 : 0);
#pragma unroll
            for (int bj = 0; bj < 2; ++bj)
#pragma unroll
                for (int n = 0; n < 2; ++n) gv[bj][n] = *(const f32x4*)(gp + bj * 32 + fq * 8 + n * 4);
        }
#pragma unroll
        for (int ai = 0; ai < 2; ++ai)
#pragma unroll
            for (int m = 0; m < 4; ++m) {
                const int row = u.pm * 256 + ai * 128 + wr * 64 + m * 16 + fr; const int t = seq_pos(row);
                f32x4 v[2][2];
#pragma unroll
                for (int bj = 0; bj < 2; ++bj)
#pragma unroll
                    for (int n = 0; n < 2; ++n) v[bj][n] = acc[ai][bj][m][n];
                if (kind == 1 || kind == 2) {
                    float ss = 0.f;
#pragma unroll
                    for (int bj = 0; bj < 2; ++bj)
#pragma unroll
                        for (int n = 0; n < 2; ++n) { const f32x4 x = v[bj][n]; ss += (x.x * x.x + x.y * x.y) + (x.z * x.z + x.w * x.w); }
                    ss += __shfl_xor(ss, 16); ss += __shfl_xor(ss, 32);
                    const float rinv = rsqrtf(ss * (1.f / 64.f) + EPS) ;
                    const float sc = (kind == 1) ? QSCALE : 1.f;
#pragma unroll
                    for (int bj = 0; bj < 2; ++bj) { const int pos = bj == 0 ? (t >> 6) : (t & 63);
#pragma unroll
                        for (int n = 0; n < 2; ++n) { const f32x4 cs = *(const f32x4*)(axtab + (pos * 16 + 4 * fq + 2 * n) * 2);
                            v[bj][n] = rot4(v[bj][n] * rinv * gv[bj][n], cs) * sc; } }
                } else if (kind == 3 || kind == 4) {
                    const float sc = (kind == 4) ? 0.125f : 1.f;
#pragma unroll
                    for (int bj = 0; bj < 2; ++bj)
#pragma unroll
                        for (int n = 0; n < 2; ++n) { const f32x4 cs = *(const f32x4*)(lintab + ((size_t)t * 32 + 16 * bj + 4 * fq + 2 * n) * 2);
                            v[bj][n] = rot4(v[bj][n], cs) * sc; }
                } else if (kind == 5) {
#pragma unroll
                    for (int bj = 0; bj < 2; ++bj)
#pragma unroll
                        for (int n = 0; n < 2; ++n) v[bj][n] = silu4(v[bj][n]);
                }
                bf16* rowp = Z + (size_t)row * NAB + colw;
#pragma unroll
                for (int bj = 0; bj < 2; ++bj) *(v4u*)(rowp + bj * 32) = pack8(v[bj][0], v[bj][1]);
            }
    }
};
struct EpiOut {
    static constexpr bool AFTER_DRAIN = false;
    const float* base0; const float* base1;
    float* out; bf16* xbf; float* part;
    __device__ __forceinline__ void operator()(const f32x4 (&acc)[2][2][4][2], const Unit& u, int wr, int wc, int fr, int fq) const {
        const int colw = u.pn * 256 + wc * 64 + fq * 8;
#pragma unroll
        for (int ai = 0; ai < 2; ++ai)
#pragma unroll
            for (int m = 0; m < 4; ++m) {
                const int row = u.pm * 256 + ai * 128 + wr * 64 + m * 16 + fr;
                const float* bp = (row < MP ? base0 + (size_t)row * DM : base1 + (size_t)(row - MP) * DM) + colw;
                float* op = out + (size_t)row * DM + colw;
                float ss = 0.f; f32x4 o[2][2];
#pragma unroll
                for (int bj = 0; bj < 2; ++bj)
#pragma unroll
                    for (int n = 0; n < 2; ++n) { const f32x4 b = *(const f32x4*)(bp + bj * 32 + n * 4); const f32x4 x = b + acc[ai][bj][m][n]; o[bj][n] = x;
                        ss += (x.x * x.x + x.y * x.y) + (x.z * x.z + x.w * x.w); }
#pragma unroll
                for (int bj = 0; bj < 2; ++bj)
#pragma unroll
                    for (int n = 0; n < 2; ++n) *(f32x4*)(op + bj * 32 + n * 4) = o[bj][n];
                if (xbf) {
#pragma unroll
                    for (int bj = 0; bj < 2; ++bj) *(v4u*)(xbf + (size_t)row * DM + colw + bj * 32) = pack8(o[bj][0], o[bj][1]);
                }
                ss += __shfl_xor(ss, 16); ss += __shfl_xor(ss, 32);
                if (fq == 0) part[(size_t)row * 16 + u.pn * 4 + wc] = ss;
            }
    }
};
struct EpiInC {
    static constexpr bool AFTER_DRAIN = false;
    bf16* Z; const float* part;
    __device__ __forceinline__ void operator()(const f32x4 (&acc)[2][2][4][2], const Unit& u, int wr, int wc, int fr, int fq) const {
        const int pn = u.pn; const int kind = pn < 4 ? 1 : (pn == 4 ? 0 : 5);
        const int colw = pn * 256 + wc * 64 + fq * 8;
#pragma unroll
        for (int ai = 0; ai < 2; ++ai)
#pragma unroll
            for (int m = 0; m < 4; ++m) {
                const int row = u.pm * 256 + ai * 128 + wr * 64 + m * 16 + fr;
                const f32x4* pp = (const f32x4*)(part + (size_t)row * 16);
                const f32x4 p0 = pp[0], p1 = pp[1], p2 = pp[2], p3 = pp[3];
                const float s = ((p0.x + p0.y) + (p0.z + p0.w)) + ((p1.x + p1.y) + (p1.z + p1.w)) + ((p2.x + p2.y) + (p2.z + p2.w)) + ((p3.x + p3.y) + (p3.z + p3.w));
                float rstd = rsqrtf(s * (1.f / DM) + EPS); if (kind == 1) rstd *= QSCALE;
                bf16* rowp = Z + (size_t)row * NCC + colw;
#pragma unroll
                for (int bj = 0; bj < 2; ++bj) { f32x4 a = acc[ai][bj][m][0] * rstd, b = acc[ai][bj][m][1] * rstd;
                    if (kind == 5) { a = silu4(a); b = silu4(b); }
                    *(v4u*)(rowp + bj * 32) = pack8(a, b); }
            }
    }
};

struct Frame {
    LAS unsigned char* lds;
    volatile LAS unsigned* MISC;
    int tid, lane, wave, vcu, G;
};
__device__ __forceinline__ int tid_now() { int t = threadIdx.x; asm volatile("" : "+v"(t)); return t; }
__device__ __forceinline__ float wave_sum(float v) {
#pragma unroll
    for (int o = 1; o < 64; o <<= 1) v += __shfl_xor(v, o);
    return v;
}
__device__ __forceinline__ int remap_ab(int n0) { return n0 < 768 ? n0 : (n0 < 1280 ? n0 + 1024 : (n0 < 2304 ? n0 - 512 : n0)); }
__device__ __forceinline__ void p0_transpose_item(const float* W, int K, int N, const float* g, bool remap, bf16* WT, LAS float* scr, int item, int lane) {
    const int nblk = N / 32, kb = item / nblk, nb = item % nblk, k0 = 64 * kb, n0 = 32 * nb;
    const int d0 = remap ? remap_ab(n0) : n0;
#pragma unroll 8
    for (int i = 0; i < 32; ++i) { const int kk = 2 * i + (lane >> 5); const float gs = g ? g[k0 + kk] : 1.f; scr[kk * 33 + (lane & 31)] = W[(size_t)(k0 + kk) * N + n0 + (lane & 31)] * gs; }
    LDS_WAIT(); asm volatile("" ::: "memory");
    const int c = lane & 7;
#pragma unroll
    for (int j = 0; j < 4; ++j) { const int n = (lane >> 3) + 8 * j; const LAS float* s = scr + (8 * c) * 33 + n;
        v4u o; o.x = pk2(s[0 * 33], s[1 * 33]); o.y = pk2(s[2 * 33], s[3 * 33]); o.z = pk2(s[4 * 33], s[5 * 33]); o.w = pk2(s[6 * 33], s[7 * 33]);
        *(GAS v4u*)(WT + (size_t)(d0 + n) * K + k0 + 8 * c) = o; }
    LDS_WAIT(); asm volatile("" ::: "memory");
}
__device__ __forceinline__ void rms_row_to_bf16(int lane, const float* xrow, bf16* orow) {
    const GAS f32x4* xr = (const GAS f32x4*)xrow + lane;
    f32x4 v[4]; float s = 0.f;
#pragma unroll
    for (int j = 0; j < 4; ++j) { v[j] = xr[64 * j]; s += (v[j].x * v[j].x + v[j].y * v[j].y) + (v[j].z * v[j].z + v[j].w * v[j].w); }
    const float rstd = rsqrtf(wave_sum(s) * (1.f / DM) + EPS);
    GAS unsigned long long* o8 = (GAS unsigned long long*)orow + lane;
#pragma unroll
    for (int j = 0; j < 4; ++j) o8[64 * j] = (unsigned long long)pk2(v[j].x * rstd, v[j].y * rstd) | ((unsigned long long)pk2(v[j].z * rstd, v[j].w * rstd) << 32);
}

__device__ __forceinline__ int t5_bucket(int rel) {
    const int d = rel < 0 ? -rel : rel; int b;
    if (d < 8) b = d; else if (d < 12) b = 8; else if (d < 16) b = 9; else if (d < 23) b = 10; else if (d < 32) b = 11; else if (d < 46) b = 12; else if (d < 64) b = 13; else if (d < 91) b = 14; else b = 15;
    return b + (rel > 0 ? 16 : 0);
}
template <int MODE> __device__ __forceinline__ void sc_attn_item(Frame& F, bf16* Z, int item, const float* sink, const float* rel_bias) {
    constexpr int LD = MODE == 0 ? NAB : NCC;
    const int h = item >> 6, bq = item & 63, row0 = bq * 512;
    const int sbase = row0 < MP ? (row0 & ~4095) : (MP + ((row0 - MP) & ~2047)), slen = row0 < MP ? 4096 : 2048;
    const int qcol = (MODE == 0 ? ZA_Q : ZC_Q) + h * 64, kcol = MODE == 0 ? ZA_K + (h >> 2) * 64 : ZC_K + (h >> 3) * 64, vcol = MODE == 0 ? ZA_V + (h >> 2) * 64 : ZC_V + (h >> 3) * 64;
    const int gcol = (MODE == 0 ? ZA_G : ZC_G) + h * 64;
    LAS float* Kt = (LAS float*)(F.lds + RING_OFF); LAS float* Vt = Kt + 64 * 64; LAS float* tab = Vt + 64 * 64;
    const int row = row0 + F.tid, ipos = row - sbase;
    float q[64], o[64];
    { const v4u* qp = (const v4u*)(Z + (size_t)row * LD + qcol);
#pragma unroll
      for (int c = 0; c < 8; ++c) { const v4u w = qp[c]; q[8 * c + 0] = bf_lo(w.x); q[8 * c + 1] = bf_hi(w.x); q[8 * c + 2] = bf_lo(w.y); q[8 * c + 3] = bf_hi(w.y); q[8 * c + 4] = bf_lo(w.z); q[8 * c + 5] = bf_hi(w.z); q[8 * c + 6] = bf_lo(w.w); q[8 * c + 7] = bf_hi(w.w); } }
#pragma unroll
    for (int d = 0; d < 64; ++d) o[d] = 0.f;
    float mrun = -1e30f, lrun = 0.f;
    int k_lo = 0, k_hi = slen;
    if (MODE == 1) {
        __syncthreads();
        if (F.tid < 257) tab[F.tid] = rel_bias[t5_bucket(F.tid - 128) * 16 + h] * LOG2E;
        mrun = sink[h] * LOG2E; lrun = 1.f;
        const int p0 = row0 - sbase; k_lo = p0 - 128 < 0 ? 0 : p0 - 128; k_hi = p0 + 512 + 128 > slen ? slen : p0 + 512 + 128;
    }
    for (int k0 = k_lo; k0 < k_hi; k0 += 64) {
        __syncthreads();
        { const int key = F.tid >> 3, ch = F.tid & 7; const bf16* rp = Z + (size_t)(sbase + k0 + key) * LD;
          const v4u kw = *(const v4u*)(rp + kcol + ch * 8), vw = *(const v4u*)(rp + vcol + ch * 8);
          LAS float* kd = Kt + key * 64 + ch * 8; LAS float* vd = Vt + key * 64 + ch * 8;
          kd[0] = bf_lo(kw.x); kd[1] = bf_hi(kw.x); kd[2] = bf_lo(kw.y); kd[3] = bf_hi(kw.y); kd[4] = bf_lo(kw.z); kd[5] = bf_hi(kw.z); kd[6] = bf_lo(kw.w); kd[7] = bf_hi(kw.w);
          vd[0] = bf_lo(vw.x); vd[1] = bf_hi(vw.x); vd[2] = bf_lo(vw.y); vd[3] = bf_hi(vw.y); vd[4] = bf_lo(vw.z); vd[5] = bf_hi(vw.z); vd[6] = bf_lo(vw.w); vd[7] = bf_hi(vw.w); }
        __syncthreads();
        for (int j = 0; j < 64; ++j) {
            const int rel = k0 + j - ipos;
            if (MODE == 1 && (rel > 128 || rel < -128)) continue;
            const LAS f32x4* kr = (const LAS f32x4*)(Kt + j * 64);
            float s0 = 0.f, s1 = 0.f, s2 = 0.f, s3 = 0.f;
#pragma unroll
            for (int c = 0; c < 16; ++c) { const f32x4 kv = kr[c]; s0 += q[4 * c] * kv.x; s1 += q[4 * c + 1] * kv.y; s2 += q[4 * c + 2] * kv.z; s3 += q[4 * c + 3] * kv.w; }
            float s = (s0 + s1) + (s2 + s3);
            if (MODE == 1) s += tab[rel + 128];
            const float mn = fmaxf(mrun, s), al = __builtin_amdgcn_exp2f(mrun - mn), p = __builtin_amdgcn_exp2f(s - mn);
            mrun = mn; lrun = lrun * al + p;
            const LAS f32x4* vr = (const LAS f32x4*)(Vt + j * 64);
#pragma unroll
            for (int c = 0; c < 16; ++c) { const f32x4 vv = vr[c]; o[4 * c] = o[4 * c] * al + p * vv.x; o[4 * c + 1] = o[4 * c + 1] * al + p * vv.y; o[4 * c + 2] = o[4 * c + 2] * al + p * vv.z; o[4 * c + 3] = o[4 * c + 3] * al + p * vv.w; }
        }
    }
    const float il = 1.f / lrun;
    v4u* gp = (v4u*)(Z + (size_t)row * LD + gcol);
#pragma unroll
    for (int c = 0; c < 8; ++c) { const v4u g = gp[c]; v4u w;
        w.x = pk2(o[8 * c + 0] * il * bf_lo(g.x), o[8 * c + 1] * il * bf_hi(g.x)); w.y = pk2(o[8 * c + 2] * il * bf_lo(g.y), o[8 * c + 3] * il * bf_hi(g.y));
        w.z = pk2(o[8 * c + 4] * il * bf_lo(g.z), o[8 * c + 5] * il * bf_hi(g.z)); w.w = pk2(o[8 * c + 6] * il * bf_lo(g.w), o[8 * c + 7] * il * bf_hi(g.w)); gp[c] = w; }
}
__device__ __forceinline__ void sc_ret_item(Frame& F, bf16* Z, int item, const float* ret_decay) {
    const int h = item >> 7, bq = item & 127, row0 = bq * 256;
    const int sbase = row0 < MP ? (row0 & ~4095) : (MP + ((row0 - MP) & ~2047)), slen = row0 < MP ? 4096 : 2048;
    const int qcol = ZB_Q + h * 64, kcol = ZB_K + h * 64, vcol = ZB_V + h * 128, gcol = ZB_G + h * 128;
    LAS float* Kt = (LAS float*)(F.lds + RING_OFF); LAS float* Vt = Kt + 64 * 64;
    const int row = row0 + (F.tid >> 1), half = F.tid & 1, ipos = row - sbase;
    const float lgf = -__expf(ret_decay[h]) * LOG2E, lgb = -__expf(ret_decay[4 + h]) * LOG2E;
    float q[64], o[64];
    { const v4u* qp = (const v4u*)(Z + (size_t)row * NAB + qcol);
#pragma unroll
      for (int c = 0; c < 8; ++c) { const v4u w = qp[c]; q[8 * c + 0] = bf_lo(w.x); q[8 * c + 1] = bf_hi(w.x); q[8 * c + 2] = bf_lo(w.y); q[8 * c + 3] = bf_hi(w.y); q[8 * c + 4] = bf_lo(w.z); q[8 * c + 5] = bf_hi(w.z); q[8 * c + 6] = bf_lo(w.w); q[8 * c + 7] = bf_hi(w.w); } }
#pragma unroll
    for (int d = 0; d < 64; ++d) o[d] = 0.f;
    for (int k0 = 0; k0 < slen; k0 += 64) {
        __syncthreads();
        { const int key = F.tid >> 3, ch = F.tid & 7; const bf16* rp = Z + (size_t)(sbase + k0 + key) * NAB;
          const v4u kw = *(const v4u*)(rp + kcol + ch * 8), vw = *(const v4u*)(rp + vcol + ch * 8), vw2 = *(const v4u*)(rp + vcol + 64 + ch * 8);
          LAS float* kd = Kt + key * 64 + ch * 8; LAS float* vd = Vt + key * 128 + ch * 8; LAS float* vd2 = vd + 64;
          kd[0] = bf_lo(kw.x); kd[1] = bf_hi(kw.x); kd[2] = bf_lo(kw.y); kd[3] = bf_hi(kw.y); kd[4] = bf_lo(kw.z); kd[5] = bf_hi(kw.z); kd[6] = bf_lo(kw.w); kd[7] = bf_hi(kw.w);
          vd[0] = bf_lo(vw.x); vd[1] = bf_hi(vw.x); vd[2] = bf_lo(vw.y); vd[3] = bf_hi(vw.y); vd[4] = bf_lo(vw.z); vd[5] = bf_hi(vw.z); vd[6] = bf_lo(vw.w); vd[7] = bf_hi(vw.w);
          vd2[0] = bf_lo(vw2.x); vd2[1] = bf_hi(vw2.x); vd2[2] = bf_lo(vw2.y); vd2[3] = bf_hi(vw2.y); vd2[4] = bf_lo(vw2.z); vd2[5] = bf_hi(vw2.z); vd2[6] = bf_lo(vw2.w); vd2[7] = bf_hi(vw2.w); }
        __syncthreads();
        for (int j = 0; j < 64; ++j) {
            const int d = ipos - (k0 + j);
            const float w = d >= 0 ? __builtin_amdgcn_exp2f(lgf * (float)d) : __builtin_amdgcn_exp2f(lgb * (float)(-d));
            const LAS f32x4* kr = (const LAS f32x4*)(Kt + j * 64);
            float s0 = 0.f, s1 = 0.f, s2 = 0.f, s3 = 0.f;
#pragma unroll
            for (int c = 0; c < 16; ++c) { const f32x4 kv = kr[c]; s0 += q[4 * c] * kv.x; s1 += q[4 * c + 1] * kv.y; s2 += q[4 * c + 2] * kv.z; s3 += q[4 * c + 3] * kv.w; }
            const float s = ((s0 + s1) + (s2 + s3)) * w;
            const LAS f32x4* vr = (const LAS f32x4*)(Vt + j * 128 + half * 64);
#pragma unroll
            for (int c = 0; c < 16; ++c) { const f32x4 vv = vr[c]; o[4 * c] += s * vv.x; o[4 * c + 1] += s * vv.y; o[4 * c + 2] += s * vv.z; o[4 * c + 3] += s * vv.w; }
        }
    }
    float ss = 0.f;
#pragma unroll
    for (int d = 0; d < 64; ++d) ss += o[d] * o[d];
    ss += __shfl_xor(ss, 1);
    const float r = rsqrtf(ss * (1.f / 128.f) + EPS);
    v4u* gp = (v4u*)(Z + (size_t)row * NAB + gcol + half * 64);
#pragma unroll
    for (int c = 0; c < 8; ++c) { const v4u g = gp[c]; v4u w;
        w.x = pk2(o[8 * c + 0] * r * bf_lo(g.x), o[8 * c + 1] * r * bf_hi(g.x)); w.y = pk2(o[8 * c + 2] * r * bf_lo(g.y), o[8 * c + 3] * r * bf_hi(g.y));
        w.z = pk2(o[8 * c + 4] * r * bf_lo(g.z), o[8 * c + 5] * r * bf_hi(g.z)); w.w = pk2(o[8 * c + 6] * r * bf_lo(g.w), o[8 * c + 7] * r * bf_hi(g.w)); gp[c] = w; }
}

using abf16 = attn_body::bf16;
__device__ __forceinline__ void attn_a_phase(Frame& F, bf16* Zu, char* shm) {
    abf16* Z = (abf16*)Zu;
    for (int idx = F.vcu; idx < 512; idx += F.G) {
        const int qb = idx & 15, g = (idx >> 4) & 3, kvh = (idx >> 6) & 1, seq = idx >> 7, h = kvh * 4 + g; const long rb = (long)seq * 4096;
        attn_body::attn_unit<8, 0, NAB>(Z + (rb + qb * 256) * NAB + ZA_Q + h * 64, Z + rb * NAB + ZA_K + kvh * 64, Z + rb * NAB + ZA_V + kvh * 64, Z + (rb + qb * 256) * NAB + ZA_G + h * 64, 64, shm, 0, 0.f);
    }
    for (int idx = F.vcu; idx < 512; idx += F.G) {
        const int qb = idx & 7, g = (idx >> 3) & 3, kvh = (idx >> 5) & 1, seq = idx >> 6, h = kvh * 4 + g; const long rb = (long)MP + (long)seq * 2048;
        attn_body::attn_unit<8, 0, NAB>(Z + (rb + qb * 256) * NAB + ZA_Q + h * 64, Z + rb * NAB + ZA_K + kvh * 64, Z + rb * NAB + ZA_V + kvh * 64, Z + (rb + qb * 256) * NAB + ZA_G + h * 64, 32, shm, 0, 0.f);
    }
}
__device__ __forceinline__ void attn_c_phase(Frame& F, bf16* Zu, char* shm, const float* sink, const float* rel_bias) {
    abf16* Z = (abf16*)Zu;
    LAS float* tab = (LAS float*)(F.lds + RING_OFF + attn_body::LDS_TAB);
    for (int grp = F.vcu; grp < 256; grp += F.G) {
        const int qbg = grp >> 1, kvh = grp & 1, row0 = qbg * 256;
        const int sbase = row0 < MP ? (row0 & ~4095) : (MP + ((row0 - MP) & ~2047)), slen = row0 < MP ? 4096 : 2048;
        const int p0 = row0 - sbase, k_lo = p0 - 128 < 0 ? 0 : p0 - 128, k_hi = p0 + 384 > slen ? slen : p0 + 384, NT = (k_hi - k_lo) >> 6;
        for (int g = 0; g < 8; ++g) {
            const int h = kvh * 8 + g;
            for (int i = tid_now(); i < 768; i += NWAVES * 64) { const int rel = i - 383; tab[i] = (rel >= -128 && rel <= 128) ? rel_bias[t5_bucket(rel) * 16 + h] * LOG2E : -1e30f; }
            attn_body::attn_unit<8, 1, NCC>(Z + (long)row0 * NCC + ZC_Q + h * 64, Z + (long)(sbase + k_lo) * NCC + ZC_K + kvh * 64, Z + (long)(sbase + k_lo) * NCC + ZC_V + kvh * 64,
                                           Z + (long)row0 * NCC + ZC_G + h * 64, NT, shm, (k_lo - p0) + 383, sink[h] * LOG2E);
        }
    }
}

namespace ret {
typedef short bf16x8 __attribute__((ext_vector_type(8)));
typedef short s16x4 __attribute__((ext_vector_type(4)));
typedef short v4i16_t __attribute__((ext_vector_type(4)));
typedef float f32x16 __attribute__((ext_vector_type(16)));
typedef __attribute__((address_space(3))) const char* lds_cptr;
__device__ __forceinline__ int crow(int r, int hi) { return (r & 3) + 8 * (r >> 2) + 4 * hi; }
__device__ __forceinline__ s16x4 vtr(lds_cptr p) { return __builtin_bit_cast(s16x4, __builtin_amdgcn_ds_read_tr16_b64_v4i16((__attribute__((address_space(3))) v4i16_t*)p)); }
__device__ __forceinline__ bf16x8 frag_tr(lds_cptr p0, lds_cptr p1) { const s16x4 a = vtr(p0), b = vtr(p1); return (bf16x8){a[0], a[1], a[2], a[3], b[0], b[1], b[2], b[3]}; }
__device__ __forceinline__ unsigned cvtpk(float lo, float hi) { typedef float f2 __attribute__((ext_vector_type(2))); typedef __bf16 b2 __attribute__((ext_vector_type(2))); f2 v = {lo, hi}; b2 b = __builtin_convertvector(v, b2); return __builtin_bit_cast(unsigned, b); }
__device__ __forceinline__ v4u scale8(v4u w, float s) { v4u o;
#pragma unroll
    for (int e = 0; e < 4; ++e) o[e] = cvtpk(__builtin_bit_cast(float, w[e] << 16) * s, __builtin_bit_cast(float, w[e] & 0xffff0000u) * s);
    return o; }

__device__ __forceinline__ void scan_unit(Frame& F, const bf16* Z, bf16* ST, const float* ret_decay, int su) {
    int seq, h, dir, nc, sbase;
    if (su < 32) { seq = su >> 3; h = (su >> 1) & 3; dir = su & 1; nc = 32; sbase = seq * 4096; }
    else { const int s2 = su - 32; seq = s2 >> 3; h = (s2 >> 1) & 3; dir = s2 & 1; nc = 16; sbase = MP + seq * 2048; }
    const int tid = tid_now(), lane = tid & 63, w = F.wave, dt = w >> 2, et = w & 3, r32 = lane & 31, hi = lane >> 5;
    const float lg2 = -__expf(ret_decay[dir * 4 + h]) * LOG2E, cdec = __builtin_amdgcn_exp2f(lg2 * 128.f);
    LAS unsigned char* Kimg = F.lds + RING_OFF; LAS unsigned char* Vimg = Kimg + 16384;
    const int g = lane >> 4, q = (lane & 15) >> 2, p = lane & 3;
    const lds_cptr ka = (lds_cptr)Kimg + (8 * (g >> 1) + q) * 128 + (32 * dt + 16 * (g & 1) + 4 * p) * 2;
    const lds_cptr va = (lds_cptr)Vimg + (8 * (g >> 1) + q) * 256 + (32 * et + 16 * (g & 1) + 4 * p) * 2;
    f32x16 acc;
#pragma unroll
    for (int r = 0; r < 16; ++r) acc[r] = 0.f;
    const bf16* Kg = Z + (size_t)sbase * NAB + ZB_K + h * 64; const bf16* Vg = Z + (size_t)sbase * NAB + ZB_V + h * 128;
    v4u kr[2], vr[4];
    { const int n0 = dir == 0 ? 0 : nc - 1;
#pragma unroll
      for (int i = 0; i < 2; ++i) { const int pc = tid + 512 * i; kr[i] = *(const v4u*)(Kg + (size_t)(n0 * 128 + (pc >> 3)) * NAB + (pc & 7) * 8); }
#pragma unroll
      for (int i = 0; i < 4; ++i) { const int pc = tid + 512 * i; vr[i] = *(const v4u*)(Vg + (size_t)(n0 * 128 + (pc >> 4)) * NAB + (pc & 15) * 8); } }
    for (int step = 0; step < nc; ++step) {
        const int n = dir == 0 ? step : nc - 1 - step;
        { bf16* st = ST + ((((size_t)(sbase >> 7) + n) * 4 + h) * 2 + dir) * 8192 + (size_t)(32 * et + r32) * 64 + 32 * dt + 4 * hi;
#pragma unroll
          for (int rq = 0; rq < 4; ++rq) { unsigned long long v = (unsigned long long)cvtpk(acc[4 * rq], acc[4 * rq + 1]) | ((unsigned long long)cvtpk(acc[4 * rq + 2], acc[4 * rq + 3]) << 32);
              *(unsigned long long*)(st + 8 * rq) = v; } }
        __syncthreads();
#pragma unroll
        for (int i = 0; i < 2; ++i) { const int pc = tid + 512 * i, tok = pc >> 3; const float kd = __builtin_amdgcn_exp2f(lg2 * (float)(dir == 0 ? 127 - tok : tok));
            *(LAS v4u*)(Kimg + tok * 128 + (pc & 7) * 16) = scale8(kr[i], kd); }
#pragma unroll
        for (int i = 0; i < 4; ++i) { const int pc = tid + 512 * i; *(LAS v4u*)(Vimg + (pc >> 4) * 256 + (pc & 15) * 16) = vr[i]; }
        if (step + 1 < nc) { const int n1 = dir == 0 ? step + 1 : nc - 2 - step;
#pragma unroll
            for (int i = 0; i < 2; ++i) { const int pc = tid + 512 * i; kr[i] = *(const v4u*)(Kg + (size_t)(n1 * 128 + (pc >> 3)) * NAB + (pc & 7) * 8); }
#pragma unroll
            for (int i = 0; i < 4; ++i) { const int pc = tid + 512 * i; vr[i] = *(const v4u*)(Vg + (size_t)(n1 * 128 + (pc >> 4)) * NAB + (pc & 15) * 8); } }
        __syncthreads();
#pragma unroll
        for (int r = 0; r < 16; ++r) acc[r] *= cdec;
#pragma unroll
        for (int s = 0; s < 8; ++s) {
            const bf16x8 a = frag_tr(ka + s * 16 * 128, ka + s * 16 * 128 + 4 * 128), b = frag_tr(va + s * 16 * 256, va + s * 16 * 256 + 4 * 256);
            acc = __builtin_amdgcn_mfma_f32_32x32x16_bf16(a, b, acc, 0, 0, 0);
        }
    }
    __syncthreads();
}

__device__ __forceinline__ void out_unit(Frame& F, bf16* Z, const bf16* ST, const float* ret_decay, int unit) {
    const int cg = unit >> 1, hp = unit & 1, R0 = cg * 128;
    const int tid = tid_now(), lane = tid & 63, w = F.wave, hl = w >> 2, hh = 2 * hp + hl, ib = w & 3, r32 = lane & 31, hi = lane >> 5;
    const float lgf = -__expf(ret_decay[hh]) * LOG2E, lgb = -__expf(ret_decay[4 + hh]) * LOG2E;
    LAS unsigned char* Vimg = F.lds + RING_OFF + hl * 32768;
    LAS unsigned char* stg = F.lds + RING_OFF + 65536 + w * 8192;
    __syncthreads();
    { const int t4 = tid & 255; const bf16* Vg = Z + (size_t)R0 * NAB + ZB_V + hh * 128;
#pragma unroll
      for (int i = 0; i < 8; ++i) { const int pc = t4 + 256 * i; const v4u v = *(const v4u*)(Vg + (size_t)(pc >> 4) * NAB + (pc & 15) * 8); *(LAS v4u*)(Vimg + (pc >> 4) * 256 + (pc & 15) * 16) = v; } }
    bf16x8 qf[4];
    { const bf16* Qg = Z + (size_t)(R0 + 32 * ib + r32) * NAB + ZB_Q + hh * 64 + 8 * hi;
#pragma unroll
      for (int ks = 0; ks < 4; ++ks) qf[ks] = *(const bf16x8*)(Qg + 16 * ks); }
    int irow = 32 * ib + r32;
    asm volatile("" : "+v"(irow));
    v4u pw[4][2];
#pragma unroll
    for (int jt = 0; jt < 4; ++jt) {
        const bf16* Kg = Z + (size_t)(R0 + 32 * jt + r32) * NAB + ZB_K + hh * 64 + 8 * hi;
        f32x16 s;
#pragma unroll
        for (int r = 0; r < 16; ++r) s[r] = 0.f;
#pragma unroll
        for (int ks = 0; ks < 4; ++ks) { const bf16x8 kf = *(const bf16x8*)(Kg + 16 * ks); s = __builtin_amdgcn_mfma_f32_32x32x16_bf16(kf, qf[ks], s, 0, 0, 0); }
#pragma unroll
        for (int r = 0; r < 16; ++r) { const int d = irow - (32 * jt + crow(r, hi));
            const float wgt = d >= 0 ? __builtin_amdgcn_exp2f(lgf * (float)d) : __builtin_amdgcn_exp2f(lgb * (float)(-d)); s[r] *= wgt; }
#pragma unroll
        for (int sI = 0; sI < 2; ++sI) { pw[jt][sI].x = cvtpk(s[8 * sI], s[8 * sI + 1]); pw[jt][sI].y = cvtpk(s[8 * sI + 2], s[8 * sI + 3]); pw[jt][sI].z = cvtpk(s[8 * sI + 4], s[8 * sI + 5]); pw[jt][sI].w = cvtpk(s[8 * sI + 6], s[8 * sI + 7]); }
        asm volatile("" ::: "memory");
    }
    f32x16 o[4];
#pragma unroll
    for (int e = 0; e < 4; ++e)
#pragma unroll
        for (int r = 0; r < 16; ++r) o[e][r] = 0.f;
#pragma unroll
    for (int dir = 0; dir < 2; ++dir) {
        const float qd = dir == 0 ? __builtin_amdgcn_exp2f(lgf * (float)(irow + 1)) : __builtin_amdgcn_exp2f(lgb * (float)(128 - irow));
        const bf16* Sg = ST + (((size_t)cg * 4 + hh) * 2 + dir) * 8192 + (size_t)r32 * 64 + 8 * hi;
#pragma unroll
        for (int ks = 0; ks < 4; ++ks) { const bf16x8 qs = __builtin_bit_cast(bf16x8, scale8(__builtin_bit_cast(v4u, qf[ks]), qd));
#pragma unroll
            for (int e = 0; e < 4; ++e) { const bf16x8 sf = *(const bf16x8*)(Sg + (size_t)(32 * e) * 64 + 16 * ks); o[e] = __builtin_amdgcn_mfma_f32_32x32x16_bf16(qs, sf, o[e], 0, 0, 0); }
            asm volatile("" ::: "memory"); }
    }
    __syncthreads();
    { const int g = lane >> 4, q = (lane & 15) >> 2, p = lane & 3;
      const lds_cptr va = (lds_cptr)Vimg + (4 * (g >> 1) + q) * 256 + (16 * (g & 1) + 4 * p) * 2;
#pragma unroll
      for (int jt = 0; jt < 4; ++jt)
#pragma unroll
          for (int sI = 0; sI < 2; ++sI)
{
#pragma unroll
              for (int e = 0; e < 4; ++e) { const lds_cptr vp = va + (32 * jt + 16 * sI) * 256 + 64 * e;
                  const bf16x8 vf = frag_tr(vp, vp + 8 * 256); o[e] = __builtin_amdgcn_mfma_f32_32x32x16_bf16(__builtin_bit_cast(bf16x8, pw[jt][sI]), vf, o[e], 0, 0, 0); }
              asm volatile("" ::: "memory"); } }
    float rn[16];
#pragma unroll
    for (int r = 0; r < 16; ++r) { float ssq = (o[0][r] * o[0][r] + o[1][r] * o[1][r]) + (o[2][r] * o[2][r] + o[3][r] * o[3][r]);
        ssq += __shfl_xor(ssq, 1); ssq += __shfl_xor(ssq, 2); ssq += __shfl_xor(ssq, 4); ssq += __shfl_xor(ssq, 8); ssq += __shfl_xor(ssq, 16);
        rn[r] = rsqrtf(ssq * (1.f / 128.f) + EPS); }
    { LAS unsigned short* sp = (LAS unsigned short*)stg;
#pragma unroll
      for (int r = 0; r < 16; ++r)
#pragma unroll
          for (int e = 0; e < 4; ++e) sp[crow(r, hi) * 128 + 32 * e + r32] = (unsigned short)f2bf(o[e][r] * rn[r]); }
    LDS_WAIT(); asm volatile("" ::: "memory");
    { bf16* Gg = Z + (size_t)(R0 + 32 * ib) * NAB + ZB_G + hh * 128;
#pragma unroll
      for (int c = 0; c < 8; ++c) { const int idx = c * 64 + lane, row = idx >> 4, ch = idx & 15;
          const v4u v = *(LAS v4u*)(stg + row * 256 + ch * 16); v4u* gp = (v4u*)(Gg + (size_t)row * NAB + ch * 8); const v4u gt = *gp; v4u wv;
#pragma unroll
          for (int e = 0; e < 4; ++e) wv[e] = cvtpk(__builtin_bit_cast(float, v[e] << 16) * __builtin_bit_cast(float, gt[e] << 16), __builtin_bit_cast(float, v[e] & 0xffff0000u) * __builtin_bit_cast(float, gt[e] & 0xffff0000u));
          *gp = wv; } }
}
}
#ifndef MK_N_LAUNCHES
#define MK_N_LAUNCHES 1
#endif
constexpr int N_PHASES = 9;
struct Args { const float* in[12]; float* out; unsigned char* ws; int ph_lo, ph_hi; };
__global__ void __launch_bounds__(NWAVES * 64, 2) mk_fwd(Args args) {
    extern __shared__ __attribute__((aligned(16))) unsigned char lds[];
    Frame F;
    F.lds = (LAS unsigned char*)lds;
    F.MISC = (volatile LAS unsigned*)(F.lds + MISC_OFF);
    F.tid = threadIdx.x; F.lane = F.tid & 63; F.wave = __builtin_amdgcn_readfirstlane((int)threadIdx.x >> 6);
    F.G = gridDim.x; { const int bx = blockIdx.x; F.vcu = (F.G % 8 == 0) ? (bx % 8) * (F.G / 8) + bx / 8 : bx; }
    unsigned char* ws = args.ws;
    unsigned* ctl = (unsigned*)(ws + WS_CTL);
    const float* x_prompt = args.in[0]; const float* x_sample = args.in[1]; const float* norm_g = args.in[2]; const float* w_in_ab = args.in[3];
    const float* qk_norm = args.in[4]; const float* ret_decay = args.in[5]; const float* w_out_ab = args.in[6]; const float* w_in_c = args.in[7];
    const float* sink_c = args.in[8]; const float* w_out_c = args.in[9]; const float* rel_bias = args.in[10]; const float* final_norm = args.in[11];
    float* out = args.out;
    bf16* XN0 = (bf16*)((unsigned char*)out + OUT_XN); bf16* WAB = (bf16*)((unsigned char*)out + OUT_WAB);
    bf16* WOAB = (bf16*)(ws + WS_WOAB); bf16* WC = (bf16*)(ws + WS_WC); bf16* WOC = (bf16*)(ws + WS_WOC);
    bf16* Z = (bf16*)(ws + WS_Z); bf16* X1B = (bf16*)(ws + WS_B); bf16* ST = (bf16*)(ws + WS_B);
    float* AXT = (float*)(ws + WS_AXT); float* LINT = (float*)(ws + WS_LINT); float* PART1 = (float*)(ws + WS_PART1); float* PART2 = (float*)(ws + WS_PART2);

    for (int u = F.tid; u < (LDS_BYTES - LDSCTL_OFF) / 4; u += NWAVES * 64) ((LAS unsigned*)(F.lds + LDSCTL_OFF))[u] = 0u;
    __syncthreads();
    const int lo = args.ph_lo, hi = args.ph_hi;
    XcdBarrier bar; bar.bar = ctl + CW_BAR; bar.x = 0; bar.st = nullptr;
    if (hi - lo > 1) bar = xcd_barrier_post(ctl + CW_BAR, F.MISC + 8);
#define IN(k) (lo <= (k) && (k) < hi)
#define SEAM(k) do { if (IN(k) && IN((k) + 1)) xcd_barrier(bar); } while (0)

    if (IN(0)) {
        const int tid0 = tid_now(), lane0 = tid0 & 63;
        LAS float* scr = (LAS float*)(F.lds + RING_OFF + F.wave * 16384);
        const int gw = F.vcu * NWAVES + F.wave, NGW = F.G * NWAVES;
        constexpr int I_AB = 16 * (NAB / 32), I_O = 16 * 32, I_C = 16 * (NCC / 32);
        constexpr int NITEMS = I_AB + I_O + I_C + I_O;
        for (int it = gw; it < NITEMS; it += NGW) {
            int r = it;
            if (r < I_AB) { p0_transpose_item(w_in_ab, DM, NAB, norm_g, true, WAB, scr, r, lane0); continue; } r -= I_AB;
            if (r < I_O) { p0_transpose_item(w_out_ab, DM, DM, nullptr, false, WOAB, scr, r, lane0); continue; } r -= I_O;
            if (r < I_C) { p0_transpose_item(w_in_c, DM, NCC, norm_g + DM, false, WC, scr, r, lane0); continue; } r -= I_C;
            p0_transpose_item(w_out_c, DM, DM, nullptr, false, WOC, scr, r, lane0);
        }
        for (int m = gw; m < MROWS; m += NGW) rms_row_to_bf16(lane0, m < MP ? x_prompt + (size_t)m * DM : x_sample + (size_t)(m - MP) * DM, XN0 + (size_t)m * DM);
        const int gt = blockIdx.x * (NWAVES * 64) + tid0, NGT = F.G * NWAVES * 64;
        for (int e = gt; e < 64 * 16 + 4096 * 32; e += NGT) {
            double ang; float* dst;
            if (e < 1024) { const int pos = e >> 4, j = e & 15; ang = (double)pos * pow(10000.0, -(double)j / 16.0); dst = AXT + 2 * e; }
            else { const int e2 = e - 1024, t = e2 >> 5, j = e2 & 31; ang = (double)t * pow(10000.0, -(double)j / 32.0); dst = LINT + 2 * e2; }
            dst[0] = (float)cos(ang); dst[1] = (float)sin(ang);
        }
    }
    SEAM(0);
    if (IN(1)) {
        pg8::Gemm g{XN0, WAB, MROWS, NAB, DM, DM}; pg8::StaticOrder S; S.init(MROWS, NAB, F.G, (int)blockIdx.x);
        EpiInAB E{Z, qk_norm, AXT, LINT};
        pg8::gemm_phase<EpiInAB, pg8::StaticOrder, true, true>(F.lds + RING_OFF, g, S, E);
    }
    SEAM(1);
    if (IN(2)) {
#ifdef SCALAR_B
        attn_a_phase(F, Z, (char*)lds + RING_OFF);
        for (int it = blockIdx.x; it < 512; it += F.G) sc_ret_item(F, Z, it, ret_decay);
        __syncthreads();
#else
        for (int su = F.vcu; su < 96; su += F.G) ret::scan_unit(F, Z, ST, ret_decay, su);
        attn_a_phase(F, Z, (char*)lds + RING_OFF);
#endif
    }
    SEAM(2);
#ifndef SCALAR_B
    if (IN(3)) { for (int u = F.vcu; u < 512; u += F.G) ret::out_unit(F, Z, ST, ret_decay, u); }
    SEAM(3);
#endif
    if (IN(4)) {
        pg8::Gemm g{Z + ZA_G, WOAB, MROWS, DM, DM, NAB}; pg8::StaticOrder S; S.init(MROWS, DM, F.G, (int)blockIdx.x);
        EpiOut E{x_prompt, x_sample, out, X1B, PART1};
        pg8::gemm_phase<EpiOut, pg8::StaticOrder, true, true>(F.lds + RING_OFF, g, S, E);
    }
    SEAM(4);
    if (IN(5)) {
        pg8::Gemm g{X1B, WC, MROWS, NCC, DM, DM}; pg8::StaticOrder S; S.init(MROWS, NCC, F.G, (int)blockIdx.x);
        EpiInC E{Z, PART1};
        pg8::gemm_phase<EpiInC, pg8::StaticOrder, true, true>(F.lds + RING_OFF, g, S, E);
    }
    SEAM(5);
    if (IN(6)) {
        attn_c_phase(F, Z, (char*)lds + RING_OFF, sink_c, rel_bias);
    }
    SEAM(6);
    if (IN(7)) {
        pg8::Gemm g{Z + ZC_G, WOC, MROWS, DM, DM, NCC}; pg8::StaticOrder S; S.init(MROWS, DM, F.G, (int)blockIdx.x);
        EpiOut E{out, out + (size_t)MP * DM, out, nullptr, PART2};
        pg8::gemm_phase<EpiOut, pg8::StaticOrder, true, true>(F.lds + RING_OFF, g, S, E);
    }
    SEAM(7);
    if (IN(8)) {
        const int gw = F.vcu * NWAVES + F.wave, NGW = F.G * NWAVES, lane8 = tid_now() & 63;
        for (int m = gw; m < MROWS; m += NGW) {
            const f32x4* pp = (const f32x4*)(PART2 + (size_t)m * 16);
            const f32x4 p0 = pp[0], p1 = pp[1], p2 = pp[2], p3 = pp[3];
            const float s = ((p0.x + p0.y) + (p0.z + p0.w)) + ((p1.x + p1.y) + (p1.z + p1.w)) + ((p2.x + p2.y) + (p2.z + p2.w)) + ((p3.x + p3.y) + (p3.z + p3.w));
            const float rstd = rsqrtf(s * (1.f / DM) + EPS);
            f32x4* xr = (f32x4*)(out + (size_t)m * DM) + lane8; const f32x4* gr = (const f32x4*)final_norm + lane8;
#pragma unroll
            for (int j = 0; j < 4; ++j) xr[64 * j] = xr[64 * j] * rstd * gr[64 * j];
        }
    }
#undef IN
#undef SEAM
}

extern "C" void kernel_launch(void* const* d_in, const int* in_sizes, int n_in, void* d_out, int out_size, void* d_ws, size_t ws_size, hipStream_t stream) {
    static int grid = 0;
    if (grid == 0) {
        if (n_in != 12 || out_size != MROWS * DM || ws_size < WS_END) { fprintf(stderr, "kernel_launch: unexpected shapes (n_in %d, out %d, ws %zu)\n", n_in, out_size, ws_size); grid = -1; return; }
        int dev = 0, cus = 0, per_cu = 0;
        if (hipGetDevice(&dev) != hipSuccess || hipDeviceGetAttribute(&cus, hipDeviceAttributeMultiprocessorCount, dev) != hipSuccess) { grid = -1; return; }
        if (hipFuncSetAttribute((const void*)mk_fwd, hipFuncAttributeMaxDynamicSharedMemorySize, LDS_BYTES) != hipSuccess) { fprintf(stderr, "kernel_launch: hipFuncSetAttribute failed\n"); grid = -1; return; }
        if (hipOccupancyMaxActiveBlocksPerMultiprocessor(&per_cu, (const void*)mk_fwd, NWAVES * 64, LDS_BYTES) != hipSuccess || per_cu < 1) { fprintf(stderr, "kernel_launch: occupancy query says %d blocks per CU\n", per_cu); grid = -1; (void)hipGetLastError(); return; }
        grid = cus;
    }
    if (grid < 0) return;
    (void)hipMemsetAsync((char*)d_ws + WS_CTL, 0, CTL_ZERO_BYTES, stream);
    Args a{};
    for (int i = 0; i < 12; ++i) a.in[i] = (const float*)d_in[i];
    a.out = (float*)d_out; a.ws = (unsigned char*)d_ws;
#if MK_N_LAUNCHES == 1
    a.ph_lo = 0; a.ph_hi = N_PHASES;
    void* kargs[] = {&a};
    hipError_t e = hipLaunchCooperativeKernel((const void*)mk_fwd, dim3(grid), dim3(NWAVES * 64), kargs, LDS_BYTES, stream);
    if (e != hipSuccess) fprintf(stderr, "kernel_launch: cooperative launch failed: %s\n", hipGetErrorString(e));
#else
    for (int p = 0; p < N_PHASES; ++p) { if (p == 3) continue; a.ph_lo = p; a.ph_hi = p + 1; hipLaunchKernelGGL(mk_fwd, dim3(grid), dim3(NWAVES * 64), LDS_BYTES, stream, a); }
#endif
}
```
